# Optimizing an MI355X kernel written in HIP

```python
import jax, jax.numpy as jnp
from jax import lax
import numpy as np

D_MODEL = 1024
BATCH = 2
SEQ = 8192
DEPTH = 2

CHUNK = 64
POOL_WIDTH = 256
POOL_GROUPS = 4
POOL_WINDOWS = (2, 4, 8, 16)
MLA_HEADS = 8
Q_LORA = 256
KV_LORA = 128
QK_NOPE = 64
QK_ROPE = 32
V_HEAD = 64
ROPE_THETA = 10000.0
Q_BLOCK = 128
CONV_WIDTH = 256
CONV_K = 31
SGU_WIDTH = 256
SGU_GROUPS = 4
SGU_LEN = 128
N_BRANCH = 4
D_FF = 2816
N_EXPERTS = 8
TOP_K = 2
D_FF_EXPERT = 3584
N_DENSE = (DEPTH + 1) // 2
N_MOE = DEPTH // 2
EPS = 1e-6

IN_SIZES = (POOL_WIDTH, Q_LORA, KV_LORA, QK_ROPE, 2 * CONV_WIDTH, 2 * SGU_WIDTH, N_BRANCH * D_MODEL)
D_IN = sum(IN_SIZES)
IN_SPLITS = tuple(sum(IN_SIZES[:i + 1]) for i in range(len(IN_SIZES) - 1))

kernel_name = "hybrid_gated_mixers_moe_encoder"


def rmsnorm(x, g):
    xf = x.astype(jnp.float32)
    y = xf * lax.rsqrt(jnp.mean(xf * xf, axis=-1, keepdims=True) + EPS)
    return (y * g.astype(jnp.float32)).astype(x.dtype)


def layernorm(x, g, b):
    xf = x.astype(jnp.float32)
    mu = jnp.mean(xf, axis=-1, keepdims=True)
    var = jnp.mean(jnp.square(xf - mu), axis=-1, keepdims=True)
    y = (xf - mu) * lax.rsqrt(var + EPS)
    return (y * g.astype(jnp.float32) + b.astype(jnp.float32)).astype(x.dtype)


def rope_tables(seq):
    pos = jnp.arange(seq, dtype=jnp.float32)
    inv = ROPE_THETA ** (-jnp.arange(0, QK_ROPE, 2, dtype=jnp.float32) / QK_ROPE)
    ang = pos[:, None] * inv[None, :]
    return jnp.cos(ang), jnp.sin(ang)


def apply_rope(x, cos, sin):
    half = x.shape[-1] // 2
    cos = cos.astype(x.dtype)
    sin = sin.astype(x.dtype)
    x1, x2 = x[..., :half], x[..., half:]
    return jnp.concatenate([x1 * cos - x2 * sin, x2 * cos + x1 * sin], axis=-1)


def pool_mixer(z, w_pool, pool_scale):
    b, s, c = z.shape
    cg = c // POOL_GROUPS
    zf = z.astype(jnp.float32)
    cs = jnp.concatenate([jnp.zeros((b, 1, c), jnp.float32), jnp.cumsum(zf, axis=1)], axis=1)
    outs = []
    for g, w in enumerate(POOL_WINDOWS):
        sl = slice(g * cg, (g + 1) * cg)
        upper = cs[:, 1:, sl]
        lower = jnp.concatenate([jnp.zeros((b, w - 1, cg), jnp.float32), cs[:, :s - w + 1, sl]], axis=1)
        cnt = jnp.minimum(jnp.arange(s) + 1, w).astype(jnp.float32)[None, :, None]
        outs.append((upper - lower) / cnt)
    pooled = (jnp.concatenate(outs, axis=-1) - zf).astype(z.dtype).reshape(b, s, POOL_GROUPS, cg)
    y = jnp.einsum('bsgc,gcd->bsgd', pooled, w_pool).reshape(b, s, c)
    return y * pool_scale


def mla_mixer(c_q_raw, c_kv_raw, k_rope_raw, q_norm_g, w_uq, kv_norm_g, w_ukv, cos, sin):
    b, s, _ = c_q_raw.shape
    h = MLA_HEADS
    q = (rmsnorm(c_q_raw, q_norm_g) @ w_uq).reshape(b, s, h, QK_NOPE + QK_ROPE)
    q_nope = q[..., :QK_NOPE]
    q_rope = apply_rope(q[..., QK_NOPE:], cos[None, :, None, :], sin[None, :, None, :])
    kv = (rmsnorm(c_kv_raw, kv_norm_g) @ w_ukv).reshape(b, s, h, QK_NOPE + V_HEAD)
    k_nope, v = kv[..., :QK_NOPE], kv[..., QK_NOPE:]
    k_rope = apply_rope(k_rope_raw, cos[None], sin[None])
    scale = (QK_NOPE + QK_ROPE) ** -0.5
    nb = s // Q_BLOCK
    qn_b = q_nope.reshape(b, nb, Q_BLOCK, h, QK_NOPE).transpose(1, 0, 2, 3, 4)
    qr_b = q_rope.reshape(b, nb, Q_BLOCK, h, QK_ROPE).transpose(1, 0, 2, 3, 4)
    k_chunk = jnp.arange(s) // CHUNK

    def attend(args):
        qn, qr, i = args
        sc = (jnp.einsum('bqhd,bkhd->bhqk', qn, k_nope, preferred_element_type=jnp.float32)
              + jnp.einsum('bqhr,bkr->bhqk', qr, k_rope, preferred_element_type=jnp.float32))
        q_chunk = (i * Q_BLOCK + jnp.arange(Q_BLOCK)) // CHUNK
        mask = k_chunk[None, :] <= q_chunk[:, None]
        sc = jnp.where(mask, sc * scale, -1e30)
        p = jax.nn.softmax(sc, axis=-1).astype(v.dtype)
        return jnp.einsum('bhqk,bkhd->bqhd', p, v)

    o = lax.map(attend, (qn_b, qr_b, jnp.arange(nb)))
    return o.transpose(1, 0, 2, 3, 4).reshape(b, s, h * V_HEAD)


def conv_mixer(z2, conv_w, conv_b, ln_g, ln_b):
    a, gt = jnp.split(z2, 2, axis=-1)
    u = a * jax.nn.sigmoid(gt)
    y = lax.conv_general_dilated(u, conv_w[:, None, :], window_strides=(1,),
                                 padding=((CONV_K - 1, 0),),
                                 dimension_numbers=('NWC', 'WIO', 'NWC'),
                                 feature_group_count=CONV_WIDTH) + conv_b
    return jax.nn.silu(layernorm(y, ln_g, ln_b))


def sgu_mixer(z2, ln_g, ln_b, w_s, b_s):
    z2 = jax.nn.gelu(z2, approximate=False)
    u, v = jnp.split(z2, 2, axis=-1)
    v = layernorm(v, ln_g, ln_b)
    b, s, c = v.shape
    n = s // SGU_LEN
    cg = c // SGU_GROUPS
    vb = v.reshape(b, n, SGU_LEN, SGU_GROUPS, cg)
    causal = jnp.tril(jnp.ones((SGU_LEN, SGU_LEN), dtype=bool))
    ws = jnp.where(causal[None], w_s, jnp.zeros_like(w_s))
    mixed = jnp.einsum('gts,bnsgc->bntgc', ws, vb) + b_s.T[None, None, :, :, None]
    return u * mixed.reshape(b, s, c)


def swiglu(h, wg, wu, wd):
    return (jax.nn.silu(h @ wg) * (h @ wu)) @ wd


def moe_ffn(h, w_router, b_router, wg, wu, wd):
    b, s, d = h.shape
    t = h.reshape(-1, d)
    logits = (t @ w_router).astype(jnp.float32) + b_router.astype(jnp.float32)
    vals, idx = lax.top_k(logits, TOP_K)
    wts = jax.nn.softmax(vals, axis=-1)
    combine = jnp.sum(jax.nn.one_hot(idx, N_EXPERTS, dtype=jnp.float32) * wts[..., None], axis=1).astype(t.dtype)
    acc = jnp.zeros_like(t)
    for e in range(N_EXPERTS):
        acc = acc + combine[:, e:e + 1] * swiglu(t, wg[e], wu[e], wd[e])
    return acc.reshape(b, s, d)


def setup_inputs(seed: int = 0) -> dict:
    key = jax.random.key(seed)
    ks = iter(jax.random.split(key, 64))
    L = DEPTH

    def nrm(shape, scale):
        return jax.random.normal(next(ks), shape, jnp.float32) * scale

    def gain(shape):
        return 1.0 + 0.02 * jax.random.normal(next(ks), shape, jnp.float32)

    cgp = POOL_WIDTH // POOL_GROUPS
    inp = {}
    inp['x'] = nrm((BATCH, SEQ, D_MODEL), 1.0)
    inp['norm_mix_g'] = gain((L, D_MODEL))
    inp['w_in'] = nrm((L, D_MODEL, D_IN), D_MODEL ** -0.5)
    inp['b_gate'] = nrm((L, N_BRANCH * D_MODEL), 0.02)
    inp['w_pool'] = nrm((L, POOL_GROUPS, cgp, cgp), cgp ** -0.5)
    inp['pool_scale'] = gain((L, POOL_WIDTH))
    inp['w_pool_out'] = nrm((L, POOL_WIDTH, D_MODEL), POOL_WIDTH ** -0.5)
    inp['q_norm_g'] = gain((L, Q_LORA))
    inp['w_uq'] = nrm((L, Q_LORA, MLA_HEADS * (QK_NOPE + QK_ROPE)), Q_LORA ** -0.5)
    inp['kv_norm_g'] = gain((L, KV_LORA))
    inp['w_ukv'] = nrm((L, KV_LORA, MLA_HEADS * (QK_NOPE + V_HEAD)), KV_LORA ** -0.5)
    inp['w_mla_out'] = nrm((L, MLA_HEADS * V_HEAD, D_MODEL), (MLA_HEADS * V_HEAD) ** -0.5)
    inp['conv_w'] = nrm((L, CONV_K, CONV_WIDTH), CONV_K ** -0.5)
    inp['conv_b'] = nrm((L, CONV_WIDTH), 0.02)
    inp['conv_ln_g'] = gain((L, CONV_WIDTH))
    inp['conv_ln_b'] = nrm((L, CONV_WIDTH), 0.02)
    inp['w_conv_out'] = nrm((L, CONV_WIDTH, D_MODEL), CONV_WIDTH ** -0.5)
    inp['sgu_ln_g'] = gain((L, SGU_WIDTH // 1 // 1 if False else SGU_WIDTH))
    inp['sgu_ln_b'] = nrm((L, SGU_WIDTH), 0.02)
    inp['sgu_w'] = nrm((L, SGU_GROUPS, SGU_LEN, SGU_LEN), SGU_LEN ** -0.5)
    inp['sgu_b'] = gain((L, SGU_GROUPS, SGU_LEN))
    inp['w_sgu_out'] = nrm((L, SGU_WIDTH, D_MODEL), SGU_WIDTH ** -0.5)
    inp['w_o'] = nrm((L, D_MODEL, D_MODEL), 0.5 * D_MODEL ** -0.5)
    inp['norm_ffn_g'] = gain((L, D_MODEL))
    inp['w_ffn_gate'] = nrm((N_DENSE, D_MODEL, D_FF), D_MODEL ** -0.5)
    inp['w_ffn_up'] = nrm((N_DENSE, D_MODEL, D_FF), D_MODEL ** -0.5)
    inp['w_ffn_down'] = nrm((N_DENSE, D_FF, D_MODEL), D_FF ** -0.5)
    inp['w_router'] = nrm((N_MOE, D_MODEL, N_EXPERTS), D_MODEL ** -0.5)
    inp['b_router'] = nrm((N_MOE, N_EXPERTS), 0.01)
    inp['w_moe_gate'] = nrm((N_MOE, N_EXPERTS, D_MODEL, D_FF_EXPERT), D_MODEL ** -0.5)
    inp['w_moe_up'] = nrm((N_MOE, N_EXPERTS, D_MODEL, D_FF_EXPERT), D_MODEL ** -0.5)
    inp['w_moe_down'] = nrm((N_MOE, N_EXPERTS, D_FF_EXPERT, D_MODEL), D_FF_EXPERT ** -0.5)
    inp['final_norm_g'] = gain((D_MODEL,))
    return inp


def reference(x, norm_mix_g, w_in, b_gate, w_pool, pool_scale, w_pool_out, q_norm_g, w_uq,
              kv_norm_g, w_ukv, w_mla_out, conv_w, conv_b, conv_ln_g, conv_ln_b, w_conv_out,
              sgu_ln_g, sgu_ln_b, sgu_w, sgu_b, w_sgu_out, w_o, norm_ffn_g, w_ffn_gate,
              w_ffn_up, w_ffn_down, w_router, b_router, w_moe_gate, w_moe_up, w_moe_down,
              final_norm_g):
    b, s, d = x.shape
    cos, sin = rope_tables(s)
    for l in range(DEPTH):
        h = rmsnorm(x, norm_mix_g[l])
        z = h @ w_in[l]
        zp, cq, ckv, kr, zc, zs, zg = jnp.split(z, IN_SPLITS, axis=-1)
        y_pool = pool_mixer(zp, w_pool[l], pool_scale[l]) @ w_pool_out[l]
        y_mla = mla_mixer(cq, ckv, kr, q_norm_g[l], w_uq[l], kv_norm_g[l], w_ukv[l], cos, sin) @ w_mla_out[l]
        y_conv = conv_mixer(zc, conv_w[l], conv_b[l], conv_ln_g[l], conv_ln_b[l]) @ w_conv_out[l]
        y_sgu = sgu_mixer(zs, sgu_ln_g[l], sgu_ln_b[l], sgu_w[l], sgu_b[l]) @ w_sgu_out[l]
        gates = jax.nn.sigmoid(zg + b_gate[l]).reshape(b, s, N_BRANCH, d)
        merged = (gates[:, :, 0] * y_pool + gates[:, :, 1] * y_mla
                  + gates[:, :, 2] * y_conv + gates[:, :, 3] * y_sgu)
        x = x + merged @ w_o[l]
        h = rmsnorm(x, norm_ffn_g[l])
        if l % 2 == 0:
            j = l // 2
            x = x + swiglu(h, w_ffn_gate[j], w_ffn_up[j], w_ffn_down[j])
        else:
            j = l // 2
            x = x + moe_ffn(h, w_router[j], b_router[j], w_moe_gate[j], w_moe_up[j], w_moe_down[j])
    return rmsnorm(x, final_norm_g)
```

```cpp
#include <hip/hip_runtime.h>
#include <hip/hip_bf16.h>
#include <cstdio>
#include <cstdint>
#include <cmath>

#ifndef GATE_I8
#define GATE_I8 1
#endif
#ifndef MOE_UP_F8
#define MOE_UP_F8 1
#endif
#ifndef NLAUNCH_MODE
#define NLAUNCH_MODE 1
#endif

__device__ __forceinline__ int lane_id() { return (int)__builtin_amdgcn_mbcnt_hi(~0u, __builtin_amdgcn_mbcnt_lo(~0u, 0u)); }
namespace pg8 {
#define PG8_LAS __attribute__((address_space(3)))
typedef unsigned short bf16_t;
typedef short bf16x8 __attribute__((ext_vector_type(8)));
typedef float f32x4 __attribute__((ext_vector_type(4)));
typedef unsigned u32x4 __attribute__((ext_vector_type(4)));
typedef int i32x4 __attribute__((ext_vector_type(4)));
typedef int i32x8 __attribute__((ext_vector_type(8)));
constexpr int BM = 256, BK = 64, HALF = 128, HTB = HALF * BK * 2, STAGE_BYTES = 8 * HTB, NXCD = 8, WGM = 8;
constexpr int SCB_OFF = 132096;
constexpr int IDX_OFF = 136192;

__host__ __device__ __forceinline__ int lds_byte(int r, int c) { const int st = (r >> 4) * 2 + (c >> 5), rr = r & 15, cc = c & 31, ob = rr * 64 + cc * 2; return st * 1024 + (ob ^ (((ob >> 9) & 1) << 5)); }
__host__ __device__ __forceinline__ void stage_rc(int b, int& R, int& C) { const int st = b / 1024, sb = b % 1024, swz = sb ^ (((sb >> 9) & 1) << 5); R = (st >> 1) * 16 + swz / 64; C = (st & 1) * 32 + (swz % 64) / 2; }
__host__ __device__ __forceinline__ int perm32(int rho) { const int n = rho >> 4, i = rho & 15; return 8 * (i >> 2) + 4 * n + (i & 3); }

struct Unit { int pm, pn, nt, aux; const char* A; const char* B; const int* rix; int nv; };
struct Gemm { int lda, ldb; };

struct StaticOrder {
    int nM, nN, nwg, G, c;
    __host__ __device__ void init(int M, int N, int G_, int c_) { nM = M / BM; nN = N / BM; nwg = nM * nN; G = G_; c = c_; }
    __host__ __device__ bool tile(int i, int& pm, int& pn) const { return tileL((long)i * G + c, pm, pn); }
    __host__ __device__ bool tileL(const long L, int& pm, int& pn) const {
        if (L >= nwg) return false;
        int wgid = (int)L; { const int q = nwg / NXCD, r = nwg % NXCD, xcd = wgid % NXCD, off = wgid / NXCD; wgid = (xcd < r ? xcd * (q + 1) : r * (q + 1) + (xcd - r) * q) + off; }
        const int nig = WGM * nN, gid = wgid / nig, fm = gid * WGM, gsz = (nM - fm) < WGM ? (nM - fm) : WGM;
        pm = fm + ((wgid % nig) % gsz); pn = (wgid % nig) / gsz; return true;
    }
};

__device__ __forceinline__ unsigned cvt_pk_bf16(float lo, float hi) { unsigned r; asm volatile("s_nop 1\n\tv_cvt_pk_bf16_f32 %0, %1, %2" : "=v"(r) : "v"(lo), "v"(hi)); return r; }
__device__ __forceinline__ float bf_lo(unsigned w) { return __uint_as_float(w << 16); }
__device__ __forceinline__ float bf_hi(unsigned w) { return __uint_as_float(w & 0xffff0000u); }


template <class Epi, class Sched, bool ALIGN_EPI, int I8 = 0, bool GATHER = false>
__device__ __forceinline__ void gemm_phase(PG8_LAS unsigned char* lds, const Gemm g, const Sched& S, const Epi& E, const int wid) {
    int lane = lane_id(); asm volatile("" : "+v"(lane));
    const int tid = wid * 64 + lane, wr = wid >> 2, wc = wid & 3, fr = lane & 15, fq = lane >> 4;
    unsigned voffA[2], voffB[2]; int gR[2]; unsigned gCb[2];
#pragma unroll
    for (int i = 0; i < 2; ++i) { int R, C; stage_rc(tid * 16 + i * 8192, R, C); const int Rb = Epi::PERM ? ((R & ~31) + perm32(R & 31)) : R;
        voffA[i] = (unsigned)(R * g.lda + C) * 2u; voffB[i] = (unsigned)(Rb * g.ldb + C) * 2u; gR[i] = R; gCb[i] = (unsigned)C * 2u; }
    unsigned gC[2][2], gN[2][2]; (void)gR; (void)gCb;
#pragma unroll
    for (int h = 0; h < 2; ++h)
#pragma unroll
        for (int i = 0; i < 2; ++i) { gC[h][i] = 0u; gN[h][i] = 0u; }
#define PG8_LDIDX(par, nv_, G_) do { _Pragma("unroll") for (int h_ = 0; h_ < 2; ++h_) _Pragma("unroll") for (int i_ = 0; i_ < 2; ++i_) { const int row_ = 128 * h_ + gR[i_]; \
        int tok_ = *(const PG8_LAS int*)(lds + IDX_OFF + (par) * 1024 + row_ * 4); tok_ = row_ < (nv_) ? tok_ : 0; G_[h_][i_] = (unsigned)tok_ * (unsigned)(g.lda * 2) + gCb[i_]; } } while (0)
    const size_t kstep = (size_t)(BK * 2);
    const unsigned hstepA = GATHER ? 0u : (unsigned)(HALF * g.lda * 2), hstepB = (unsigned)(HALF * g.ldb * 2);
    const unsigned ldsw = (unsigned)wid * 1024u;
    const int aoff = lds_byte(wr * 64 + fr, fq * 8), boff = lds_byte(wc * 32 + fr, fq * 8);
#define PG8_SA(b, h) (((b) * 2 + (h)) * HTB)
#define PG8_SB(b, h) ((4 + (b) * 2 + (h)) * HTB)
#define PG8_STAGE(bufoff, gbase, voff) do { _Pragma("unroll") for (int _i = 0; _i < 2; ++_i) \
        __builtin_amdgcn_global_load_lds((const unsigned*)((const char*)(gbase) + (voff)[_i]), (PG8_LAS unsigned*)(lds + (bufoff) + ldsw + _i * 8192), 16, 0, 0); } while (0)
#define PG8_LDA(dst, b, h) do { _Pragma("unroll") for (int m = 0; m < 4; ++m) _Pragma("unroll") for (int k = 0; k < 2; ++k) dst[m][k] = *(const PG8_LAS bf16x8*)(lds + PG8_SA(b, h) + aoff + m * 2048 + k * 1024); } while (0)
#define PG8_LDB(dst, b, h) do { _Pragma("unroll") for (int n = 0; n < 2; ++n) _Pragma("unroll") for (int k = 0; k < 2; ++k) dst[n][k] = *(const PG8_LAS bf16x8*)(lds + PG8_SB(b, h) + boff + n * 2048 + k * 1024); } while (0)
#define PG8_MMA_I8(ai, bj, At, Bt) do { __builtin_amdgcn_s_setprio(1); _Pragma("unroll") for (int m = 0; m < 4; ++m) _Pragma("unroll") for (int n = 0; n < 2; ++n) _Pragma("unroll") for (int k = 0; k < 2; ++k) \
            acc[ai][bj][m][n] = __builtin_bit_cast(f32x4, __builtin_amdgcn_mfma_i32_16x16x64_i8(__builtin_bit_cast(i32x4, Bt[n][k]), __builtin_bit_cast(i32x4, At[m][k]), __builtin_bit_cast(i32x4, acc[ai][bj][m][n]), 0, 0, 0)); \
        __builtin_amdgcn_s_setprio(0); } while (0)
#define PG8_MMA_F8(ai, bj, At, Bt) do { __builtin_amdgcn_s_setprio(1); _Pragma("unroll") for (int m = 0; m < 4; ++m) _Pragma("unroll") for (int n = 0; n < 2; ++n) { \
            const i32x4 bl_ = __builtin_bit_cast(i32x4, Bt[n][0]), bh_ = __builtin_bit_cast(i32x4, Bt[n][1]), al_ = __builtin_bit_cast(i32x4, At[m][0]), ah_ = __builtin_bit_cast(i32x4, At[m][1]); \
            const i32x8 b8_ = __builtin_shufflevector(bl_, bh_, 0, 1, 2, 3, 4, 5, 6, 7), a8_ = __builtin_shufflevector(al_, ah_, 0, 1, 2, 3, 4, 5, 6, 7); \
            asm volatile("v_mfma_scale_f32_16x16x128_f8f6f4 %0, %1, %2, %0, %3, %3 op_sel_hi:[0,0,0]" : "+v"(acc[ai][bj][m][n]) : "v"(b8_), "v"(a8_), "v"(f8one)); } \
        __builtin_amdgcn_s_setprio(0); } while (0)
#define PG8_MMA_BF(ai, bj, At, Bt) do { __builtin_amdgcn_s_setprio(1); _Pragma("unroll") for (int m = 0; m < 4; ++m) _Pragma("unroll") for (int n = 0; n < 2; ++n) _Pragma("unroll") for (int k = 0; k < 2; ++k) \
            acc[ai][bj][m][n] = __builtin_amdgcn_mfma_f32_16x16x32_bf16(Bt[n][k], At[m][k], acc[ai][bj][m][n], 0, 0, 0); \
        __builtin_amdgcn_s_setprio(0); } while (0)
#define PG8_WAIT_V(n) asm volatile("s_waitcnt vmcnt(" #n ")" ::: "memory")
#define PG8_WAIT_L(n) asm volatile("s_waitcnt lgkmcnt(" #n ")" ::: "memory")
#define PG8_BAR __builtin_amdgcn_s_barrier()
#define PG8_SCHED __builtin_amdgcn_sched_barrier(0)
    Unit cur, nxt; int ui = 0;
    if (!S.next(0, cur)) return;
    int f8one = 0x7F7F7F7F; if constexpr (I8 == 3) asm volatile("" : "+v"(f8one)); (void)f8one;
    unsigned gst[(I8 == 2) ? 32 : 1]; (void)gst;
    if constexpr (I8 == 2) {
#pragma unroll
        for (int i = 0; i < 32; ++i) gst[i] = 0u; }
    f32x4 acc[2][2][4][2];
#pragma unroll
    for (int a = 0; a < 2; ++a)
#pragma unroll
        for (int b = 0; b < 2; ++b)
#pragma unroll
            for (int m = 0; m < 4; ++m)
#pragma unroll
                for (int n = 0; n < 2; ++n) acc[a][b][m][n] = (f32x4){0.f, 0.f, 0.f, 0.f};
    bf16x8 At[4][2], B0[2][2], B1[2][2];
    const char* cA = cur.A; const char* cB = cur.B;
    if constexpr (GATHER) {
        if (wid == 2) __builtin_amdgcn_global_load_lds((const unsigned*)(cur.rix + lane * 4), (PG8_LAS unsigned*)(lds + IDX_OFF), 16, 0, 0);
        asm volatile("s_waitcnt vmcnt(0)" ::: "memory"); PG8_BAR; asm volatile("" ::: "memory");
        PG8_LDIDX(0, cur.nv, gC);
    }
    { unsigned p0_[2], p1_[2];
#pragma unroll
      for (int i = 0; i < 2; ++i) { p0_[i] = GATHER ? gC[0][i] : voffA[i]; p1_[i] = GATHER ? gC[1][i] : voffA[i]; }
    PG8_STAGE(PG8_SB(0, 0), cB, voffB); PG8_STAGE(PG8_SB(0, 1), cB + hstepB, voffB); PG8_STAGE(PG8_SA(0, 0), cA, p0_); PG8_STAGE(PG8_SA(0, 1), cA + hstepA, p1_);
    if (wr == 1) PG8_BAR;
    PG8_WAIT_V(2); PG8_BAR;
    PG8_STAGE(PG8_SB(1, 0), cB + kstep, voffB); PG8_STAGE(PG8_SA(1, 0), cA + kstep, p0_); PG8_STAGE(PG8_SB(1, 1), cB + hstepB + kstep, voffB); }
    PG8_WAIT_V(6); PG8_BAR;
    for (;;) {
        const bool has_next = S.next(ui + 1, nxt);
        const int nt = cur.nt; bool cur_i8 = (I8 == 1); if constexpr (I8 == 2) cur_i8 = Epi::unit_i8(cur); (void)cur_i8;
        if constexpr (GATHER) {
            if (!has_next) {
#pragma unroll
                for (int h = 0; h < 2; ++h)
#pragma unroll
                    for (int i = 0; i < 2; ++i) gN[h][i] = gC[h][i]; }
            if (wid == 2 && has_next) __builtin_amdgcn_global_load_lds((const unsigned*)(nxt.rix + lane * 4), (PG8_LAS unsigned*)(lds + IDX_OFF + ((ui + 1) & 1) * 1024), 16, 0, 0);
            if constexpr (I8 != 3) { if (wid == 1) __builtin_amdgcn_global_load_lds((const unsigned*)(E.pf_ptr(cur, 1) + lane * 4), (PG8_LAS unsigned*)(lds + SCB_OFF + (ui & 1) * 2048 + 1024), 16, 0, 0); }
            if (I8 != 3 && wid == 0) {
#pragma unroll
                for (int q = 0; q < 4; ++q) { const int row_ = 64 * q + lane; int tok_ = *(const PG8_LAS int*)(lds + IDX_OFF + (ui & 1) * 1024 + row_ * 4); tok_ = row_ < cur.nv ? tok_ : 0;
                    __builtin_amdgcn_global_load_lds((const unsigned*)(E.sx + tok_), (PG8_LAS unsigned*)(lds + SCB_OFF + (ui & 1) * 2048 + q * 256), 4, 0, 0); } }
        } else
        if constexpr (I8 == 1 || I8 == 2) { if (wid < 2) { const float* sp_ = E.pf_ptr(cur, wid);
                int l4_ = lane_id() * 4; asm volatile("" : "+v"(l4_));
                if (sp_) __builtin_amdgcn_global_load_lds((const unsigned*)(sp_ + l4_), (PG8_LAS unsigned*)(lds + SCB_OFF + (ui & 1) * 2048 + wid * 1024), 16, 0, 0); } }
        const char* nA = has_next ? nxt.A : cA; const char* nB = has_next ? nxt.B : cB;
#define PG8_KLOOP(MMAX) \
        for (int t = 0; t < nt; t += 2) { \
            const bool last = (t == nt - 2); \
            const char* a1 = cA + (size_t)(t + 1) * kstep; \
            const char* a2 = last ? nA : cA + (size_t)(t + 2) * kstep; const char* b2 = last ? nB : cB + (size_t)(t + 2) * kstep; \
            const char* a3 = a2 + kstep; const char* b3 = b2 + kstep; \
            unsigned c1_[2], s0_[2], s1_[2]; \
            if constexpr (GATHER) { if (last && has_next) PG8_LDIDX((ui + 1) & 1, nxt.nv, gN); \
                _Pragma("unroll") for (int i = 0; i < 2; ++i) { c1_[i] = gC[1][i]; s0_[i] = last ? gN[0][i] : gC[0][i]; s1_[i] = last ? gN[1][i] : gC[1][i]; } } \
            else { _Pragma("unroll") for (int i = 0; i < 2; ++i) { c1_[i] = voffA[i]; s0_[i] = voffA[i]; s1_[i] = voffA[i]; } } \
            PG8_LDB(B0, 0, 0); PG8_LDB(B1, 0, 1); PG8_SCHED; PG8_LDA(At, 0, 0); PG8_STAGE(PG8_SA(1, 1), a1 + hstepA, c1_); \
            PG8_WAIT_V(8); PG8_WAIT_L(0); PG8_BAR; MMAX(0, 0, At, B0); MMAX(0, 1, At, B1); PG8_BAR; PG8_SCHED; \
            PG8_LDA(At, 0, 1); PG8_STAGE(PG8_SB(0, 0), b2, voffB); PG8_STAGE(PG8_SB(0, 1), b2 + hstepB, voffB); PG8_STAGE(PG8_SA(0, 0), a2, s0_); \
            PG8_WAIT_V(8); PG8_WAIT_L(0); PG8_BAR; MMAX(1, 0, At, B0); MMAX(1, 1, At, B1); PG8_BAR; PG8_SCHED; \
            PG8_LDB(B0, 1, 0); PG8_LDB(B1, 1, 1); PG8_SCHED; PG8_LDA(At, 1, 0); PG8_STAGE(PG8_SA(0, 1), a2 + hstepA, s1_); \
            PG8_WAIT_V(8); PG8_WAIT_L(0); PG8_BAR; MMAX(0, 0, At, B0); MMAX(0, 1, At, B1); PG8_BAR; PG8_SCHED; \
            PG8_LDA(At, 1, 1); PG8_STAGE(PG8_SB(1, 0), b3, voffB); PG8_STAGE(PG8_SB(1, 1), b3 + hstepB, voffB); PG8_STAGE(PG8_SA(1, 0), a3, s0_); \
            PG8_WAIT_V(8); PG8_WAIT_L(0); PG8_BAR; MMAX(1, 0, At, B0); MMAX(1, 1, At, B1); PG8_BAR; PG8_SCHED; \
        }
        if constexpr (I8 == 2) { if (cur_i8) { PG8_KLOOP(PG8_MMA_I8) } else { PG8_KLOOP(PG8_MMA_BF) } }
        else if constexpr (I8 == 1) { PG8_KLOOP(PG8_MMA_I8) }
        else if constexpr (I8 == 3) { PG8_KLOOP(PG8_MMA_F8) }
        else { PG8_KLOOP(PG8_MMA_BF) }
#undef PG8_KLOOP
        if constexpr (ALIGN_EPI) { if (wr == 0) PG8_BAR; }
        if constexpr (I8 == 2) E(acc, cur, wr, wc, fr, fq, (const PG8_LAS float*)(lds + SCB_OFF + (ui & 1) * 2048), gst);
        else if constexpr (I8 == 1) E(acc, cur, wr, wc, fr, fq, (const PG8_LAS float*)(lds + SCB_OFF + (ui & 1) * 2048)); else E(acc, cur, wr, wc, fr, fq);
        if (!has_next) break;
#pragma unroll
        for (int a = 0; a < 2; ++a)
#pragma unroll
            for (int b = 0; b < 2; ++b)
#pragma unroll
                for (int m = 0; m < 4; ++m)
#pragma unroll
                    for (int n = 0; n < 2; ++n) acc[a][b][m][n] = (f32x4){0.f, 0.f, 0.f, 0.f};
        cur = nxt; cA = nA; cB = nB; ++ui;
        if constexpr (GATHER) {
#pragma unroll
            for (int h = 0; h < 2; ++h)
#pragma unroll
                for (int i = 0; i < 2; ++i) gC[h][i] = gN[h][i]; }
        if constexpr (ALIGN_EPI) { if (wr == 1) PG8_BAR; }
    }
    PG8_WAIT_V(0);
    if constexpr (!ALIGN_EPI) { if (wr == 0) PG8_BAR; }
    PG8_BAR;
#undef PG8_LDIDX
#undef PG8_SA
#undef PG8_SB
#undef PG8_STAGE
#undef PG8_LDA
#undef PG8_LDB
#undef PG8_MMA_I8
#undef PG8_MMA_BF
#undef PG8_MMA_F8
#undef PG8_WAIT_V
#undef PG8_WAIT_L
#undef PG8_BAR
#undef PG8_SCHED
}
}

constexpr int NWAVES = 8;
constexpr int BATCH = 2, SEQ = 8192, DM = 1024, M = BATCH * SEQ;
constexpr int D_IN = 5792, NZ = 5888;
constexpr int DFF = 2816, NEXP = 8, DFFE = 3584;
constexpr int KCAT = 1280;
constexpr int F_POOL = 0, F_MLA = 256, F_CONV = 768, F_SGU = 1024;
constexpr float EPS = 1e-6f;
constexpr int MOE_TILES_MAX = 136, MOE_CH = 136;

#ifndef ATT_NEGM
#define ATT_NEGM 1
#endif
namespace att2 {
using bf16=__hip_bfloat16;
using bf16x8=__attribute__((ext_vector_type(8)))short;
using s16x4=__attribute__((ext_vector_type(4)))short;
using f32x16=__attribute__((ext_vector_type(16)))float;
using u32x4=__attribute__((ext_vector_type(4)))unsigned;
constexpr int NW=8,QBLK=32,QB=QBLK*NW,KVBLK=64;
constexpr int PQ=768,PK=1024,PV=512,PO=KCAT;
__device__ __forceinline__ int crow(int r,int hi){return (r&3)+8*(r>>2)+4*hi;}
#define SBAR() __builtin_amdgcn_sched_barrier(0)
constexpr int NSLOT=3, NKSLOT=4, SLOTB=8192, KSLOTB=16384;
constexpr int LDS_K=0, LDS_V=NKSLOT*KSLOTB, LDS_WS=LDS_V+NSLOT*SLOTB, LDS_OST=LDS_WS+NW*64*4, LDS_BYTES=LDS_OST+NW*4096;
constexpr float C2=0.10206207261596575f*1.4426950408889634f;
__device__ __forceinline__ void glds16(const void*gsrc,unsigned lds_dst){unsigned keep;
  asm volatile("s_mov_b32 %0, m0\n\ts_mov_b32 m0, %2\n\ts_nop 0\n\tglobal_load_lds_dwordx4 %1, off\n\ts_mov_b32 m0, %0":"=&s"(keep):"v"(gsrc),"s"(lds_dst):"memory");}
__device__ __forceinline__ float max3f(float a,float b,float c){float r;asm("v_max3_f32 %0, %1, %2, %3":"=v"(r):"v"(a),"v"(b),"v"(c));return r;}
__device__ __forceinline__ float max2f(float a,float b){float r;asm("v_max_f32_e32 %0, %1, %2":"=v"(r):"v"(a),"v"(b));return r;}
typedef float f32x2_t __attribute__((ext_vector_type(2))); typedef __bf16 bf16x2_t __attribute__((ext_vector_type(2)));
__device__ __forceinline__ unsigned cvtpk_s(float lo,float hi){f32x2_t v={lo,hi};bf16x2_t b=__builtin_convertvector(v,bf16x2_t);return __builtin_bit_cast(unsigned,b);}
#define WAIT_BAR(N) asm volatile("s_waitcnt vmcnt(" #N ") lgkmcnt(0)\n\ts_barrier":::"memory")
__device__ __forceinline__ void qkt(f32x16&p0,f32x16&p1,const char*Kslot,const bf16x8*qr,int r32,int hi){
  const char*kb=Kslot+hi*1024+r32*16; const f32x16 z=f32x16{};
  #pragma unroll
  for(int d0=0;d0<6;++d0){
    const bf16x8 b0=*reinterpret_cast<const bf16x8*>(kb+d0*2048);
    const bf16x8 b1=*reinterpret_cast<const bf16x8*>(kb+d0*2048+512);
    if(d0==0){p0=__builtin_amdgcn_mfma_f32_32x32x16_bf16(b0,qr[0],z,0,0,0);p1=__builtin_amdgcn_mfma_f32_32x32x16_bf16(b1,qr[0],z,0,0,0);}
    else{p0=__builtin_amdgcn_mfma_f32_32x32x16_bf16(b0,qr[d0],p0,0,0,0);p1=__builtin_amdgcn_mfma_f32_32x32x16_bf16(b1,qr[d0],p1,0,0,0);}}
}
typedef __attribute__((address_space(3))) const char* lds_cptr;
typedef short v4i16_t __attribute__((ext_vector_type(4)));
__device__ __forceinline__ void kload2(bf16x8*kf,lds_cptr kp,int j){ kf[2*j]=*(const __attribute__((address_space(3))) bf16x8*)(kp+j*2048); kf[2*j+1]=*(const __attribute__((address_space(3))) bf16x8*)(kp+j*2048+512); }
__device__ __forceinline__ s16x4 vtr(lds_cptr p){ return __builtin_bit_cast(s16x4,__builtin_amdgcn_ds_read_tr16_b64_v4i16((__attribute__((address_space(3))) v4i16_t*)p)); }
__device__ __forceinline__ float rowmax(const f32x16&p0,const f32x16&p1){
  float a=max3f(p0[0],p0[1],p1[0]),b=max3f(p0[2],p0[3],p1[1]);a=max3f(a,p1[2],p1[3]);
  #pragma unroll
  for(int r=4;r<16;r+=4){a=max3f(a,p0[r],p0[r+1]);b=max3f(b,p0[r+2],p0[r+3]);a=max3f(a,p1[r],p1[r+1]);b=max3f(b,p1[r+2],p1[r+3]);}
  const float m=max2f(a,b);
  auto rr=__builtin_amdgcn_permlane32_swap(__float_as_uint(m),__float_as_uint(m),false,false);
  return max2f(__uint_as_float(rr[0]),__uint_as_float(rr[1]));
}
__device__ __forceinline__ void pv(f32x16*o,int vb,bf16x8 pa0,bf16x8 pa1,bf16x8 pa2,bf16x8 pa3){
  #pragma unroll
  for(int d0=0;d0<2;++d0){s16x4 lo[4],hi[4];
    #pragma unroll
    for(int ks=0;ks<4;++ks){
      asm volatile("ds_read_b64_tr_b16 %0,%1 offset:%c2":"=&v"(lo[ks]):"v"(vb),"i"(d0*4096+ks*1024):"memory");
      asm volatile("ds_read_b64_tr_b16 %0,%1 offset:%c2":"=&v"(hi[ks]):"v"(vb),"i"(d0*4096+ks*1024+512):"memory");}
    asm volatile("s_waitcnt lgkmcnt(0)":::"memory");SBAR();
    #define PK(k) (bf16x8){lo[k][0],lo[k][1],lo[k][2],lo[k][3],hi[k][0],hi[k][1],hi[k][2],hi[k][3]}
    o[d0]=__builtin_amdgcn_mfma_f32_32x32x16_bf16(pa0,PK(0),o[d0],0,0,0);
    o[d0]=__builtin_amdgcn_mfma_f32_32x32x16_bf16(pa1,PK(1),o[d0],0,0,0);
    o[d0]=__builtin_amdgcn_mfma_f32_32x32x16_bf16(pa2,PK(2),o[d0],0,0,0);
    o[d0]=__builtin_amdgcn_mfma_f32_32x32x16_bf16(pa3,PK(3),o[d0],0,0,0);
    #undef PK
  }
}
template<int THRL> __device__ __forceinline__ void attn_unit(int b,int h,int qb,const bf16*Q,const bf16*__restrict__ K,const bf16*__restrict__ V,bf16*O,char*shm,const int wid){
  int lane=lane_id(); asm volatile("":"+v"(lane));
  const int r32=lane&31,hi=lane>>5;
  const long rowbase=(long)b*SEQ; const int q0=qb*QB;
  const bf16*Qw=Q+(rowbase+q0+wid*QBLK)*PQ+h*96;
  const bf16*Kh=K+rowbase*PK+h*128,*Vh=V+rowbase*PV+h*64;
  const unsigned lds0=(unsigned)(uintptr_t)shm;
  float*wsf=(float*)(shm+LDS_WS)+wid*64;
  const bf16*ksrc=Kh+(long)lane*PK+wid*8;
  const bf16*vsrc=Vh+(long)(16*(wid&3)+(lane>>2))*PV+(wid>>2)*32+(lane&3)*8;
  const unsigned kdst=lds0+LDS_K+wid*1024, vdst=lds0+LDS_V+wid*1024;
  #define DMA_K(t,slot) do{ glds16(ksrc+(long)(t)*KVBLK*PK,(unsigned)__builtin_amdgcn_readfirstlane(kdst+(slot))); if(wid<4){ glds16(ksrc+64+(long)(t)*KVBLK*PK,(unsigned)__builtin_amdgcn_readfirstlane(kdst+8192+(slot))); } }while(0)
  #define WAIT_BARW(A,B) do{ if(wid<4){WAIT_BAR(A);}else{WAIT_BAR(B);} }while(0)
  #define DMA_V(t,slot) glds16(vsrc+(long)(t)*KVBLK*PV,(unsigned)__builtin_amdgcn_readfirstlane(vdst+(slot)))
  const int vb0=(int)(lds0+LDS_V)+((lane>>4)&1)*32+(lane&3)*8+(4*hi+((lane&15)>>2))*64;
  const char*Kbase=shm+LDS_K; bf16x8 kf[12];
  const lds_cptr shm3=(lds_cptr)shm; const lds_cptr kp0=shm3+LDS_K+hi*1024+r32*16; const lds_cptr vp0=shm3+LDS_V+((lane>>4)&1)*32+(lane&3)*8+(4*hi+((lane&15)>>2))*64;
  const int NT=(q0+QB)/KVBLK;
  DMA_K(0,0);DMA_V(0,0);DMA_K(1,KSLOTB);
  bf16x8 qr[6];
  #pragma unroll
  for(int d0=0;d0<6;++d0)qr[d0]=*reinterpret_cast<const bf16x8*>(&Qw[(long)r32*PQ+d0*16+hi*8]);
  float mhat=0.f,l_reg=0.f;f32x16 o[2];o[0]=f32x16{};o[1]=f32x16{};
#if ATT_NEGM
  f32x16 negm;
#endif
  const int wchunk=wid>>1;
  #define CMASK(P0,P1,t) do{int jb_=(t)-(NT-4); if(jb_>wchunk){ _Pragma("unroll") for(int r=0;r<16;++r){P0[r]=-INFINITY;P1[r]=-INFINITY;} } }while(0)
  bool resc=false;
  #define RESC() do{ if(resc){ asm volatile("s_waitcnt lgkmcnt(0)":::"memory"); \
      _Pragma("unroll") for(int d_=0;d_<2;++d_) _Pragma("unroll") for(int r=0;r<16;++r)o[d_][r]*=wsf[crow(r,hi)]; } }while(0)
  f32x16 pA0,pA1,pB0,pB1;
  int sl_prev=0,sl_cur=0,sl_next=SLOTB, kq_prev=0,kq_cur=0,kq_next=KSLOTB;
  const int grp=wid>>2;
  #define ROT() do{sl_prev=sl_cur;sl_cur=sl_next;sl_next=(sl_next==(NSLOT-1)*SLOTB)?0:sl_next+SLOTB; kq_prev=kq_cur;kq_cur=kq_next;kq_next=(kq_next==(NKSLOT-1)*KSLOTB)?0:kq_next+KSLOTB;}while(0)
  DMA_K(2,2*KSLOTB);
  WAIT_BARW(5,4);
  qkt(pA0,pA1,Kbase,qr,r32,hi);asm volatile("s_nop 15\n\ts_nop 7":"+v"(pA0),"+v"(pA1));
  { const float rm=rowmax(pA0,pA1); mhat=rm;
    _Pragma("unroll") for(int r=0;r<16;++r)pA0[r]=__builtin_amdgcn_exp2f(pA0[r]-mhat);
    _Pragma("unroll") for(int r=0;r<16;++r)pA1[r]=__builtin_amdgcn_exp2f(pA1[r]-mhat);
#if ATT_NEGM
    _Pragma("unroll") for(int r=0;r<16;++r)negm[r]=-mhat; asm volatile("":"+v"(negm));
#endif
  }
  WAIT_BAR(0);
  DMA_K(3,3*KSLOTB);DMA_V(1,SLOTB);
  ROT();
  #pragma unroll
  for(int j=0;j<6;++j)kload2(kf,kp0+kq_cur,j);
  WAIT_BARW(3,2);
  s16x4 vlo[8],vhi[8]; u32x4 pw0,pw1,pw2,pw3;
  #define PKW(P,B) cvtpk_s(P[B],P[B+1])
  #define PAF(k) __builtin_bit_cast(bf16x8,pw##k)
  #define VFR(i) (bf16x8){vlo[i][0],vlo[i][1],vlo[i][2],vlo[i][3],vhi[i][0],vhi[i][1],vhi[i][2],vhi[i][3]}
  #define PIN(x) asm volatile("":"+v"(x))
  #define MX3(a,b,c) __builtin_fmaxf(__builtin_fmaxf((a),(b)),(c))
  #define GAPA(MF,A0,A1,A2,A3,W0,W1,PW) do{ MF; sacc+=A0; sacc+=A1; sacc+=A2; sacc+=A3; PIN(sacc); W0; W1; PIN(PW); SBAR(); }while(0)
  #define GAPA2(MF,A0,A1,W0,W1,PW) do{ MF; sacc+=A0; sacc+=A1; PIN(sacc); W0; W1; PIN(PW); SBAR(); }while(0)
  #define GAPA4(MF,A0,A1,A2,A3) do{ MF; sacc+=A0; sacc+=A1; sacc+=A2; sacc+=A3; PIN(sacc); SBAR(); }while(0)
#if ATT_NEGM
  #define EX(v) __builtin_amdgcn_exp2f(v)
  #define CINIT negm
#else
  #define EX(v) __builtin_amdgcn_exp2f((v)-mhat)
  #define CINIT z_
#endif
  #define GAPB(MF,X,B) do{ MF; X[B]=EX(X[B]); X[B+1]=EX(X[B+1]); X[B+2]=EX(X[B+2]); X[B+3]=EX(X[B+3]); PIN(X); SBAR(); }while(0)
  #define VRD(i) do{ vlo[i]=vtr(vp_+(((i)>>2)*4096+((i)&3)*1024)); vhi[i]=vtr(vp_+(((i)>>2)*4096+((i)&3)*1024+512)); }while(0)
  #define KRD(G,j) do{ if(G){ kload2(kf,kp0+kq_next,j); SBAR(); } }while(0)
  #define MF_(C,kk,qq,IN) C=__builtin_amdgcn_mfma_f32_32x32x16_bf16(kf[kk],qr[qq],IN,0,0,0)
#if ATT_NEGM
  #define RMREL(rm) do{}while(0)
  #define NEGM_UPD(C0,C1,dl) do{ _Pragma("unroll") for(int r=0;r<16;++r){C0[r]-=dl;C1[r]-=dl;} _Pragma("unroll") for(int r=0;r<16;++r)negm[r]=-mhat; asm volatile("":"+v"(negm)); }while(0)
#else
  #define RMREL(rm) rm-=mhat
  #define NEGM_UPD(C0,C1,dl) do{}while(0)
#endif
  #define STEP(C0,C1,P0,P1,t,GK,GV,GL,MK,MIDW) do{ SBAR(); \
    const lds_cptr vp_=vp0+sl_prev; const f32x16 z_=f32x16{}; \
    VRD(0); SBAR(); float sacc=(P0[0]+P0[1]); \
    GAPA2(MF_(C0,0,0,CINIT), P0[2],P0[3],     pw0[0]=PKW(P0,0), pw0[1]=PKW(P0,2), pw0); \
    VRD(4); SBAR(); GAPA2(MF_(C1,1,0,CINIT), P0[4],P0[5],     pw0[2]=PKW(P0,4), pw0[3]=PKW(P0,6), pw0); \
    VRD(1); SBAR(); GAPA2(MF_(C0,2,1,C0),   P0[6],P0[7], pw1[0]=PKW(P0,8), pw1[1]=PKW(P0,10), pw1); \
    VRD(5); SBAR(); GAPA2(MF_(C1,3,1,C1),   P0[8],P0[9],   pw1[2]=PKW(P0,12),pw1[3]=PKW(P0,14), pw1); \
    VRD(2); SBAR(); GAPA2(MF_(C0,4,2,C0),   P0[10],P0[11],     pw2[0]=PKW(P1,0), pw2[1]=PKW(P1,2), pw2); \
    VRD(6); SBAR(); GAPA2(MF_(C1,5,2,C1),   P0[12],P0[13],     pw2[2]=PKW(P1,4), pw2[3]=PKW(P1,6), pw2); \
    VRD(3); SBAR(); GAPA2(MF_(C0,6,3,C0),   P0[14],P0[15], pw3[0]=PKW(P1,8), pw3[1]=PKW(P1,10), pw3); \
    VRD(7); SBAR(); GAPA2(MF_(C1,7,3,C1),   P1[0],P1[1],       pw3[2]=PKW(P1,12),pw3[3]=PKW(P1,14), pw3); \
    GAPA4(MF_(C0,8,4,C0), P1[2],P1[3],P1[4],P1[5]); GAPA4(MF_(C1,9,4,C1), P1[6],P1[7],P1[8],P1[9]); GAPA4(MF_(C0,10,5,C0), P1[10],P1[11],P1[12],P1[13]); GAPA4(MF_(C1,11,5,C1), P1[14],P1[15],0.f,0.f); \
    l_reg+=sacc; \
    if(GK){DMA_K((t)+3,kq_prev);} if(GV){DMA_V((t)+1,sl_next);} \
    if(MK){CMASK(C0,C1,t);} \
    { float a=MX3(C0[0],C0[1],C1[0]),b=MX3(C0[2],C0[3],C1[1]); a=MX3(a,C1[2],C1[3]); \
      _Pragma("unroll") for(int r=4;r<16;r+=4){a=MX3(a,C0[r],C0[r+1]);b=MX3(b,C0[r+2],C0[r+3]);a=MX3(a,C1[r],C1[r+1]);b=MX3(b,C1[r+2],C1[r+3]);} \
      float rm=__builtin_fmaxf(a,b); { auto rr=__builtin_amdgcn_permlane32_swap(__float_as_uint(rm),__float_as_uint(rm),false,false); rm=__builtin_fmaxf(__uint_as_float(rr[0]),__uint_as_float(rr[1])); } \
      RMREL(rm); resc=false; \
      if(__builtin_expect(__any(rm>(float)THRL),0)){ const float dl=__builtin_fmaxf(rm,0.f); mhat+=dl; NEGM_UPD(C0,C1,dl); \
        const float f=__builtin_amdgcn_exp2f(-dl); l_reg*=f; if(hi==0)wsf[r32]=f; resc=true; } } \
    SBAR(); MIDW; SBAR(); \
    GAPB(o[0]=__builtin_amdgcn_mfma_f32_32x32x16_bf16(PAF(0),VFR(0),o[0],0,0,0), C0,0); \
    GAPB(o[1]=__builtin_amdgcn_mfma_f32_32x32x16_bf16(PAF(0),VFR(4),o[1],0,0,0), C0,4); \
    KRD(GL,0); GAPB(o[0]=__builtin_amdgcn_mfma_f32_32x32x16_bf16(PAF(1),VFR(1),o[0],0,0,0), C0,8); \
    KRD(GL,1); GAPB(o[1]=__builtin_amdgcn_mfma_f32_32x32x16_bf16(PAF(1),VFR(5),o[1],0,0,0), C0,12); \
    KRD(GL,2); GAPB(o[0]=__builtin_amdgcn_mfma_f32_32x32x16_bf16(PAF(2),VFR(2),o[0],0,0,0), C1,0); \
    KRD(GL,3); GAPB(o[1]=__builtin_amdgcn_mfma_f32_32x32x16_bf16(PAF(2),VFR(6),o[1],0,0,0), C1,4); \
    KRD(GL,4); GAPB(o[0]=__builtin_amdgcn_mfma_f32_32x32x16_bf16(PAF(3),VFR(3),o[0],0,0,0), C1,8); \
    KRD(GL,5); GAPB(o[1]=__builtin_amdgcn_mfma_f32_32x32x16_bf16(PAF(3),VFR(7),o[1],0,0,0), C1,12); \
    }while(0)
  int t=1;
  for(;t+3<NT;t+=2){
    STEP(pB0,pB1,pA0,pA1,t,true,true,true,false,if(grp){WAIT_BAR(2);});     if(!grp){WAIT_BAR(3);} RESC(); ROT();
    STEP(pA0,pA1,pB0,pB1,t+1,true,true,true,false,if(grp){WAIT_BAR(2);});   if(!grp){WAIT_BAR(3);} RESC(); ROT();
  }
  STEP(pB0,pB1,pA0,pA1,t,false,true,true,true,if(grp){WAIT_BAR(1);});       if(!grp){WAIT_BAR(1);} RESC(); ROT();
  STEP(pA0,pA1,pB0,pB1,t+1,false,true,true,true,if(grp){WAIT_BAR(0);});     if(!grp){WAIT_BAR(0);} RESC(); ROT();
  STEP(pB0,pB1,pA0,pA1,NT-1,false,false,false,true,(void)0); RESC();
  { float sacc=pB0[0]+pB0[1]; _Pragma("unroll") for(int r=2;r<16;++r)sacc+=pB0[r]; _Pragma("unroll") for(int r=0;r<16;++r)sacc+=pB1[r]; l_reg+=sacc;
    pw0=(u32x4){PKW(pB0,0),PKW(pB0,2),PKW(pB0,4),PKW(pB0,6)};pw1=(u32x4){PKW(pB0,8),PKW(pB0,10),PKW(pB0,12),PKW(pB0,14)};pw2=(u32x4){PKW(pB1,0),PKW(pB1,2),PKW(pB1,4),PKW(pB1,6)};pw3=(u32x4){PKW(pB1,8),PKW(pB1,10),PKW(pB1,12),PKW(pB1,14)};
    SBAR(); pv(o,vb0+sl_cur,PAF(0),PAF(1),PAF(2),PAF(3)); }
  {auto rr=__builtin_amdgcn_permlane32_swap(__float_as_uint(l_reg),__float_as_uint(l_reg),false,false);l_reg=__uint_as_float(rr[0])+__uint_as_float(rr[1]);}
  if(hi==0)wsf[32+r32]=l_reg;asm volatile("s_waitcnt lgkmcnt(0)":::"memory");
  float rli[16];
  #pragma unroll
  for(int r=0;r<16;++r)rli[r]=__builtin_amdgcn_rcpf(wsf[32+crow(r,hi)]);
  bf16*Ow=O+(rowbase+q0+wid*QBLK)*PO+F_MLA+h*64;
  { bf16*stg=(bf16*)(shm+LDS_OST)+wid*2048;
    #pragma unroll
    for(int r=0;r<16;++r){const int orow=crow(r,hi);
      #pragma unroll
      for(int d0=0;d0<2;++d0)stg[orow*64+d0*32+r32]=__float2bfloat16(o[d0][r]*rli[r]);}
    asm volatile("s_waitcnt lgkmcnt(0)":::"memory");
    #pragma unroll
    for(int i=0;i<4;++i){const int row=i*8+(lane>>3),ch=lane&7; const u32x4 v=*(const u32x4*)(stg+row*64+ch*8); *(u32x4*)(Ow+(long)row*PO+ch*8)=v;} }
  asm volatile("s_waitcnt lgkmcnt(0)\n\ts_barrier":::"memory");
  #undef DMA_K
  #undef WAIT_BARW
  #undef DMA_V
  #undef CMASK
  #undef RESC
  #undef ROT
  #undef PKW
  #undef PAF
  #undef VFR
  #undef PIN
  #undef MX3
  #undef GAPA
  #undef GAPA2
  #undef GAPA4
  #undef EX
  #undef GAPB
  #undef VRD
  #undef KRD
  #undef MF_
  #undef STEP
  #undef EX
  #undef CINIT
  #undef RMREL
  #undef NEGM_UPD
}
#undef SBAR
#undef WAIT_BAR
}

constexpr size_t MiB = 1u << 20;
constexpr size_t WS_CTL = 0, CTL_ZERO_BYTES = 256 * 1024;
constexpr int XLD = 1280;
constexpr size_t SZ_WIN = (size_t)NZ * XLD * 2, SZ_WCAT = (size_t)DM * KCAT * 2, SZ_WO = (size_t)DM * DM * 2, SZ_WUQ = (size_t)768 * 256 * 2, SZ_WUKV = (size_t)1024 * 256 * 2;
constexpr size_t WS_STV = 512 * 1024;
constexpr size_t WS_TOK = 1 * MiB;
constexpr size_t WS_SSQ = WS_TOK + 384 * 1024;
constexpr size_t WS_SSK = WS_SSQ + 256 * 1024;
constexpr size_t WS_MGU = 2 * MiB;
constexpr size_t SZ_MGU = (size_t)2 * DFFE * DM * 2, SZ_MD = (size_t)DM * DFFE * 2;
constexpr size_t WS_MD = WS_MGU + 8 * SZ_MGU;
constexpr size_t SZ_MGU8 = (size_t)2 * DFFE * DM;
constexpr size_t WS_XRB = WS_MGU + 56 * MiB;
static_assert(8 * SZ_MGU8 <= 56 * MiB && WS_XRB + (size_t)16384 * 1024 * 2 <= WS_MD, "xrb");
constexpr size_t WS_A0 = WS_MD + 8 * SZ_MD;
static_assert(WS_A0 == 170 * MiB && WS_SSK + 256 * 1024 <= WS_MGU, "map");
constexpr size_t WS_XP = WS_A0;
constexpr size_t WS_HC = WS_A0 + 68 * MiB;
constexpr size_t WS_XN = WS_A0;
constexpr size_t WS_F = WS_A0 + 40 * MiB;
constexpr size_t WS_GS = WS_A0 + 80 * MiB;
constexpr size_t WS_U = WS_A0 + 96 * MiB;
constexpr size_t WS_ZP = WS_A0 + 104 * MiB;
constexpr size_t WS_ZKV = WS_A0 + 112 * MiB;
constexpr size_t WS_ZQ = WS_A0 + 120 * MiB;
constexpr size_t WS_KVRAW = WS_A0 + 128 * MiB;
constexpr size_t WS_QRAW = WS_A0 + 160 * MiB;
constexpr size_t WS_MG = WS_A0 + 184 * MiB;
constexpr size_t WS_TG = WS_A0 + 216 * MiB;
constexpr size_t WS_VB = WS_TG;
constexpr size_t WS_KF = WS_KVRAW;
constexpr size_t WS_KR = WS_A0 + 248 * MiB;
constexpr size_t WS_SXN = 478 * MiB;
constexpr size_t WS_SWGU0 = WS_SXN + 64 * 1024;
constexpr size_t WS_SWIN = WS_SWGU0 + 32 * 1024;
constexpr size_t WS_SWMOE = WS_SWIN + 64 * 1024;
constexpr size_t WS_SXP = WS_SWMOE + 256 * 1024;
constexpr size_t WS_SXQ = WS_SXP + 160 * 1024;
constexpr size_t WS_TIX = WS_SXQ + 64 * 1024;
static_assert(WS_TIX + (size_t)8 * 16384 * 4 <= 523801632ull, "tix");
constexpr size_t WS_XNQ = WS_A0 + 80 * MiB;
constexpr size_t WS_XN2 = WS_A0;
static_assert(WS_XN2 + (size_t)16384 * 2560 <= WS_HC, "XN2 must not overlap the MoE hidden buffer");
constexpr size_t WS_H = WS_A0 + 80 * MiB;
constexpr size_t WS_WIN = 420 * MiB;
constexpr size_t WS_WCAT = WS_WIN + 2 * SZ_WIN;
constexpr size_t WS_WO = WS_WCAT + 2 * SZ_WCAT;
constexpr size_t WS_WUQ = WS_WO + 2 * SZ_WO;
constexpr size_t WS_WUKV = WS_WUQ + 2 * SZ_WUQ;
constexpr size_t WS_WGU0 = WS_WUKV + 2 * SZ_WUKV;
constexpr size_t WS_WD0 = WS_WGU0 + (size_t)2 * DFF * DM * 2;
constexpr size_t WS_CS = WS_WD0 + (size_t)DM * DFF * 2;
constexpr size_t WS_END = WS_CS + (size_t)SEQ * 32 * 4;
static_assert(WS_END <= WS_SXN && WS_SXQ + (size_t)M * 4 <= 523801632ull && WS_HC + (size_t)MOE_TILES_MAX * 256 * DFFE * 2 <= WS_SXN, "scale block");
constexpr size_t WS_YF = WS_MGU;
static_assert(WS_YF + 56 * MiB <= WS_MD, "YF");
static_assert(WS_KR + (size_t)M * 32 * 2 <= WS_WIN && WS_H + (size_t)M * DFF * 2 <= WS_MG, "layer buffers");
static_assert(WS_HC + (size_t)MOE_TILES_MAX * 256 * DFFE * 2 <= 523801632ull, "moe map");
static_assert(WS_END <= 523801632ull, "d_ws budget");
constexpr int CW_CK = 16384;
constexpr int CW_TMO = 0, CW_CODE = 1, CW_BAR = 4096, CW_MOE = 8192;

constexpr int RING_BYTES = 131072, LDSCTL_OFF = RING_BYTES, MISC_OFF = LDSCTL_OFF + 320, LDS_BYTES = 147456;

#define GAS __attribute__((address_space(1)))
#define LAS __attribute__((address_space(3)))
typedef unsigned short bf16;
typedef unsigned v4u __attribute__((ext_vector_type(4)));
typedef unsigned v2u __attribute__((ext_vector_type(2)));
typedef float f32x4 __attribute__((ext_vector_type(4)));
typedef GAS unsigned gu32;
#define RLX_AGENT __ATOMIC_RELAXED, __HIP_MEMORY_SCOPE_AGENT
#define LDS_WAIT() asm volatile("s_waitcnt lgkmcnt(0)" ::: "memory")
#define VM_WAIT() asm volatile("s_waitcnt vmcnt(0)" ::: "memory")
__device__ __forceinline__ unsigned pk2(float lo, float hi) { return pg8::cvt_pk_bf16(lo, hi); }
__device__ __forceinline__ float bflo(unsigned w) { return __uint_as_float(w << 16); }
__device__ __forceinline__ float bfhi(unsigned w) { return __uint_as_float(w & 0xffff0000u); }
__device__ __forceinline__ float sigmoidf_(float x) { return __builtin_amdgcn_rcpf(1.0f + __builtin_amdgcn_exp2f(-1.4426950408889634f * x)); }
__device__ __forceinline__ float gelu_erf(float x) { return 0.5f * x * (1.0f + erff(x * 0.70710678118654752f)); }

#define XB_TMO      128
#define XB_XCNT(j)  (256  + 64 * (j))
#define XB_XSUB(j)  (1280 + 64 * (j))
#define XB_XGEN(j)  (2304 + 64 * (j))
#define XB_TOP      3328
#define XB_TOPGEN   3392
#define XCD_BAR_WORDS 3456
#define XB_SPIN_CAP (1u << 18)
__device__ __forceinline__ unsigned xb_ld(unsigned* p)              { return __hip_atomic_load(p, __ATOMIC_RELAXED, __HIP_MEMORY_SCOPE_AGENT); }
__device__ __forceinline__ unsigned xb_add(unsigned* p, unsigned v) { return __hip_atomic_fetch_add(p, v, __ATOMIC_RELAXED, __HIP_MEMORY_SCOPE_AGENT); }
__device__ __forceinline__ unsigned xb_xcc_id() { return (unsigned)__builtin_amdgcn_s_getreg((3 << 11) | 20) & 0xFu; }
#define XB_SPIN(cond, bar) do { unsigned _sp = 0; while (cond) { __builtin_amdgcn_s_sleep(1); \
    if ((++_sp & 255u) == 0u) { if (xb_ld(&(bar)[XB_TMO])) break; if (_sp > XB_SPIN_CAP) { atomicAdd(&(bar)[XB_TMO], 1u); break; } } } } while (0)
struct XcdBarrier { unsigned* bar; unsigned x; volatile LAS unsigned* st; int wave; };
__device__ __forceinline__ XcdBarrier xcd_barrier_post(unsigned* bar, volatile LAS unsigned* st) {
    XcdBarrier b; b.bar = bar; b.x = xb_xcc_id(); b.st = st;
    if (threadIdx.x == 0) (void)xb_add(&bar[XB_XCNT(b.x)], 1u);
    return b;
}
__device__ __forceinline__ void xcd_barrier_complete(unsigned* bar, unsigned x, unsigned& nloc, unsigned& nx) {
    const unsigned G = gridDim.x * gridDim.y * gridDim.z;
    unsigned sum, cnt, mine, sp = 0u;
    for (;;) {
        sum = 0u; cnt = 0u; mine = 0u;
#pragma unroll
        for (unsigned j = 0; j < 16; ++j) { const unsigned c = xb_ld(&bar[XB_XCNT(j)]); sum += c; cnt += (c > 0u) ? 1u : 0u; mine = (j == x) ? c : mine; }
        if (sum == G) break;
        __builtin_amdgcn_s_sleep(1);
        if ((++sp & 255u) == 0u) { if (xb_ld(&bar[XB_TMO])) break; if (sp > XB_SPIN_CAP) { atomicAdd(&bar[XB_TMO], 1u); break; } }
    }
    nloc = mine > 0u ? mine : 1u; nx = cnt > 0u ? cnt : 1u;
}
__device__ __forceinline__ void xcd_barrier(const XcdBarrier& b) {
    asm volatile("s_waitcnt vmcnt(0)" ::: "memory");
    __syncthreads();
    if (b.wave == 0 && lane_id() == 0) {
        unsigned* bar = b.bar;
        __builtin_amdgcn_s_waitcnt(0);
        unsigned nloc = b.st[0], nx = b.st[1];
        if (nloc == 0u) { xcd_barrier_complete(bar, b.x, nloc, nx); b.st[0] = nloc; b.st[1] = nx; }
        const unsigned old = xb_add(&bar[XB_XSUB(b.x)], 1u);
        const unsigned gen = old / nloc;
        if (old + 1u == (gen + 1u) * nloc) {
            __builtin_amdgcn_fence(__ATOMIC_RELEASE, "agent");
            asm volatile("s_waitcnt vmcnt(0)" ::: "memory");
            const unsigned og = xb_add(&bar[XB_TOP], 1u);
            const unsigned tg = og / nx;
            if (og + 1u == (tg + 1u) * nx) xb_add(&bar[XB_TOPGEN], 1u);
            else XB_SPIN(xb_ld(&bar[XB_TOPGEN]) == tg, bar);
            __builtin_amdgcn_fence(__ATOMIC_ACQUIRE, "agent");
            xb_add(&bar[XB_XGEN(b.x)], 1u);
            asm volatile("s_waitcnt vmcnt(0)" ::: "memory");
        } else {
            XB_SPIN(xb_ld(&bar[XB_XGEN(b.x)]) == gen, bar);
            __builtin_amdgcn_fence(__ATOMIC_ACQUIRE, "agent");
            asm volatile("s_waitcnt vmcnt(0)" ::: "memory");
        }
    }
    __syncthreads();
}

__device__ __forceinline__ float wave_sum(float v) {
#pragma unroll
    for (int o = 1; o < 64; o <<= 1) v += __shfl_xor(v, o);
    return v;
}

__device__ __forceinline__ float wave_max(float v) {
#pragma unroll
    for (int o = 1; o < 64; o <<= 1) v = fmaxf(v, __shfl_xor(v, o));
    return v;
}
constexpr float F8_SA = 8.0f, F8_SWU = 32.0f;
constexpr float F8_SY = 16.0f;
constexpr float F8_SH = 8.0f, F8_SW = 64.0f;
__device__ __forceinline__ unsigned f8x4(float a, float b, float c, float d) { unsigned w = 0u; w = __builtin_amdgcn_cvt_pk_fp8_f32(a, b, w, false); w = __builtin_amdgcn_cvt_pk_fp8_f32(c, d, w, true); return w; }
__device__ __forceinline__ unsigned q8x4(float a, float b, float c, float d, float inv) {
    const int qa = (int)rintf(a * inv), qb = (int)rintf(b * inv), qc = (int)rintf(c * inv), qd = (int)rintf(d * inv);
    return (unsigned)(qa & 0xff) | ((unsigned)(qb & 0xff) << 8) | ((unsigned)(qc & 0xff) << 16) | ((unsigned)(qd & 0xff) << 24);
}
__device__ __forceinline__ void quant_rows(bf16* W, int rows, int ld, float* sw, int row_begin, int row_stride) {
    const int lane = lane_id();
    for (int r0 = row_begin; r0 < rows; r0 += 4 * row_stride) {
        v4u z0[4], z1[4];
#pragma unroll
        for (int i = 0; i < 4; ++i) { const int r = r0 + i * row_stride; if (r < rows) { const bf16* rp = W + (size_t)r * ld; z0[i] = *(const v4u*)(rp + 16 * lane); z1[i] = *(const v4u*)(rp + 16 * lane + 8); } else { z0[i] = (v4u){0u, 0u, 0u, 0u}; z1[i] = z0[i]; } }
#pragma unroll
        for (int i = 0; i < 4; ++i) { const int r = r0 + i * row_stride;
            const float x[16] = {bflo(z0[i].x), bfhi(z0[i].x), bflo(z0[i].y), bfhi(z0[i].y), bflo(z0[i].z), bfhi(z0[i].z), bflo(z0[i].w), bfhi(z0[i].w), bflo(z1[i].x), bfhi(z1[i].x), bflo(z1[i].y), bfhi(z1[i].y), bflo(z1[i].z), bfhi(z1[i].z), bflo(z1[i].w), bfhi(z1[i].w)};
            float am = 0.f;
#pragma unroll
            for (int k = 0; k < 16; ++k) am = fmaxf(am, fabsf(x[k]));
            am = wave_max(am); const float sc = am > 0.f ? am * (1.f / 127.f) : 1.f, inv = am > 0.f ? 127.f / am : 0.f;
            const v4u q = (v4u){q8x4(x[0], x[1], x[2], x[3], inv), q8x4(x[4], x[5], x[6], x[7], inv), q8x4(x[8], x[9], x[10], x[11], inv), q8x4(x[12], x[13], x[14], x[15], inv)};
            if (r < rows) { *(v4u*)((unsigned char*)(W + (size_t)r * ld) + 16 * lane) = q; if (lane == 0) sw[r] = sc; } }
    }
}
__device__ __forceinline__ void quant_copy_rows(const bf16* X, unsigned char* Q, int rows, int ld, float* sx, int row_begin, int row_stride) {
    const int lane = lane_id();
    for (int r0 = row_begin; r0 < rows; r0 += 4 * row_stride) {
        v4u z0[4], z1[4];
#pragma unroll
        for (int i = 0; i < 4; ++i) { const int r = r0 + i * row_stride; if (r < rows) { const bf16* rp = X + (size_t)r * ld; z0[i] = *(const v4u*)(rp + 16 * lane); z1[i] = *(const v4u*)(rp + 16 * lane + 8); } else { z0[i] = (v4u){0u, 0u, 0u, 0u}; z1[i] = z0[i]; } }
#pragma unroll
        for (int i = 0; i < 4; ++i) { const int r = r0 + i * row_stride;
            const float x[16] = {bflo(z0[i].x), bfhi(z0[i].x), bflo(z0[i].y), bfhi(z0[i].y), bflo(z0[i].z), bfhi(z0[i].z), bflo(z0[i].w), bfhi(z0[i].w), bflo(z1[i].x), bfhi(z1[i].x), bflo(z1[i].y), bfhi(z1[i].y), bflo(z1[i].z), bfhi(z1[i].z), bflo(z1[i].w), bfhi(z1[i].w)};
            float am = 0.f;
#pragma unroll
            for (int k = 0; k < 16; ++k) am = fmaxf(am, fabsf(x[k]));
            am = wave_max(am); const float sc = am > 0.f ? am * (1.f / 127.f) : 1.f, inv = am > 0.f ? 127.f / am : 0.f;
            const v4u q = (v4u){q8x4(x[0], x[1], x[2], x[3], inv), q8x4(x[4], x[5], x[6], x[7], inv), q8x4(x[8], x[9], x[10], x[11], inv), q8x4(x[12], x[13], x[14], x[15], inv)};
            if (r < rows) { *(v4u*)(Q + (size_t)r * ld * 2 + 16 * lane) = q; if (lane == 0) sx[r] = sc; } }
    }
}
constexpr int SC_LDS_OFF = 132096;
extern __shared__ __attribute__((aligned(16))) unsigned char dyn_lds_all[];
__device__ __forceinline__ const LAS float* park_scales(float pfv, int tid) {
    LAS float* tb = (LAS float*)((LAS unsigned char*)dyn_lds_all + SC_LDS_OFF);
    tb[tid] = pfv;
    asm volatile("s_waitcnt lgkmcnt(0)" ::: "memory"); __builtin_amdgcn_s_barrier(); asm volatile("" ::: "memory");
    return tb;
}
struct TileOrder {
    pg8::StaticOrder so; const char* A; const char* B; size_t a_tile, b_tile; int nt;
    __device__ __forceinline__ bool next(int i, pg8::Unit& u) const {
        int pm, pn; if (!so.tile(i, pm, pn)) return false;
        u.pm = pm; u.pn = pn; u.nt = nt; u.aux = 0; u.A = A + (size_t)pm * a_tile; u.B = B + (size_t)pn * b_tile; return true; }
};
struct WinOrder {
    int c, G; const char* A; const char* B; size_t a_tile, b_tile; int nt;
    __device__ __forceinline__ bool next(int i, pg8::Unit& u) const {
        int rt, pn;
        if (G == 256) { const int x = c & 7, j = c >> 3;
            if (i == 0) { if (j < 16) { rt = 8 * x + (j >> 1); pn = 5 + (j & 1); } else { rt = 8 * x + ((j - 16) >> 1); pn = 3 + (j & 1); } }
            else if (i == 1) { int t; if (j >= 16) t = j - 16; else if (j < 8) t = 16 + j; else return false; rt = 8 * x + t / 3; pn = t % 3; }
            else return false;
        } else { const long L = (long)i * G + c; if (L >= 64 * 7) return false; rt = (int)(L / 7); pn = (int)(L % 7); }
        u.pm = rt; u.pn = pn; u.nt = nt; u.aux = 0; u.A = A + (size_t)rt * a_tile; u.B = B + (size_t)pn * b_tile; return true; }
};
struct BranchOrder {
    pg8::StaticOrder so; const char* XNp; const char* Wz; const char* Fp; const char* Wc;
    __device__ __forceinline__ bool next(int i, pg8::Unit& u) const {
        int pm, pn; if (!so.tile(i >> 3, pm, pn)) return false;
        const int sub = i & 7, br = sub >> 1, kind = sub & 1; u.pm = pm; u.pn = pn; u.aux = sub;
        if (kind == 0) { u.nt = GATE_I8 ? 8 : 16; u.A = XNp + (size_t)pm * 256 * XLD * 2; u.B = Wz + (size_t)(br * 1024 + pn * 256) * XLD * 2; }
        else { const int koff = (br == 0) ? F_POOL : (br == 1) ? F_MLA : (br == 2) ? F_CONV : F_SGU; u.nt = (br == 1) ? 8 : 4;
            u.A = Fp + ((size_t)pm * 256 * KCAT + koff) * 2; u.B = Wc + ((size_t)pn * 256 * KCAT + koff) * 2; }
        return true; }
};
struct MoeOrder {
    pg8::StaticOrder so; int nt; const char* A; const char* B; size_t a_tile, b_tile, b_exp; int toff[9]; const int* tix; int cnt[8];
    __device__ __forceinline__ bool next(int i, pg8::Unit& u) const {
        int rt, pn; if (!so.tile(i, rt, pn)) return false;
        int e = 0;
#pragma unroll
        for (int k = 1; k < 8; ++k) e += (rt >= toff[k]) ? 1 : 0;
        int t0 = 0, ce = 0;
#pragma unroll
        for (int k = 0; k < 8; ++k) { if (k == e) { t0 = toff[k]; ce = cnt[k]; } }
        const int j = rt - t0;
        u.pm = rt; u.pn = pn; u.nt = nt; u.aux = e; u.A = A; u.B = B + (size_t)e * b_exp + (size_t)pn * b_tile; u.rix = tix + (size_t)e * M + 256 * j; u.nv = ce - 256 * j; return true; }
};

struct MoeDownOrder {
    pg8::StaticOrder so; int G, c, nsub; const char* A; const char* B; size_t a_tile, b_tile, b_exp; int toff[9];
    __device__ __forceinline__ bool next(int i, pg8::Unit& u) const {
        const long L = (long)i * G + c; int rt, pn, ks = 0;
        if (L < nsub) { const int t = (int)L / 28, rem = (int)L % 28; rt = 128 + t; pn = rem / 7; ks = rem % 7; u.nt = 4; u.aux = 1 + ks; }
        else { if (!so.tileL(L - nsub, rt, pn)) return false; u.nt = DFFE / 128; u.aux = 0; }
        int e = 0;
#pragma unroll
        for (int k = 1; k < 8; ++k) e += (rt >= toff[k]) ? 1 : 0;
        u.pm = rt; u.pn = pn; u.A = A + (size_t)rt * a_tile + (size_t)ks * 4 * 128; u.B = B + (size_t)e * b_exp + (size_t)pn * b_tile + (size_t)ks * 4 * 128; return true; }
};
using pg8::Unit; typedef unsigned u32x4 __attribute__((ext_vector_type(4)));
typedef const f32x4 (&AccRef)[2][2][4][2];

typedef float f32x2 __attribute__((ext_vector_type(2)));
__device__ __forceinline__ f32x2 gelu_pk(f32x2 v) {
    const f32x2 av = __builtin_elementwise_abs(v), d = av * 0.2316418882f + 1.0f;
    f32x2 t; t.x = __builtin_amdgcn_rcpf(d.x); t.y = __builtin_amdgcn_rcpf(d.y);
    f32x2 q = t * 0.5307027145f + (-0.7265760135f); q = q * t + 0.7107068705f; q = q * t + (-0.142248368f); q = q * t + 0.127414796f; q = q * t;
    const f32x2 s = (v * v) * (-0.72134752044f);
    f32x2 e; e.x = __builtin_amdgcn_exp2f(s.x); e.y = __builtin_amdgcn_exp2f(s.y);
    const f32x2 m = v * (q * e), r = v - m;
    f32x2 o; o.x = v.x < 0.f ? m.x : r.x; o.y = v.y < 0.f ? m.y : r.y; return o;
}
__device__ __forceinline__ float xsum16(float v) { auto r = __builtin_amdgcn_permlane16_swap(__float_as_uint(v), __float_as_uint(v), false, false); return __uint_as_float(r[0]) + __uint_as_float(r[1]); }
__device__ __forceinline__ float xsum32(float v) { auto r = __builtin_amdgcn_permlane32_swap(__float_as_uint(v), __float_as_uint(v), false, false); return __uint_as_float(r[0]) + __uint_as_float(r[1]); }
__device__ __forceinline__ float xget32(float v, bool upper) { auto r = __builtin_amdgcn_permlane32_swap(__float_as_uint(v), __float_as_uint(v), false, false); return __uint_as_float(upper ? r[0] : r[1]); }
template <bool I8> struct EpiZ2T {
    static constexpr bool PERM = true;
    unsigned char* ws; const float* sx; const float* sw;
    __device__ __forceinline__ const float* pf_ptr(const Unit& u, int w) const { return w == 0 ? sx + u.pm * 256 : sw + u.pn * 256; }
    __device__ __forceinline__ void operator()(AccRef acc, const Unit& u, int wr, int wc, int fr, int fq) const { body(acc, u, wr, wc, fr, fq, nullptr); }
    __device__ __forceinline__ void operator()(AccRef acc, const Unit& u, int wr, int wc, int fr, int fq, const LAS float* sc) const { body(acc, u, wr, wc, fr, fq, sc); }
    __device__ __forceinline__ void body(AccRef acc, const Unit& u, int wr, int wc, int fr, int fq, const LAS float* sc) const {
        const int pn = u.pn; const int row0 = u.pm * 256 + wr * 64 + fr, cl = wc * 32 + 8 * fq;
        f32x4 swv[2][2];
        if (I8) {
#pragma unroll
            for (int bj = 0; bj < 2; ++bj)
#pragma unroll
                for (int n = 0; n < 2; ++n) swv[bj][n] = *(const LAS f32x4*)(sc + 256 + bj * 128 + cl + 4 * n); }
#define ZV(ai_, bj_, m_, n_) (I8 ? __builtin_convertvector(__builtin_bit_cast(pg8::i32x4, acc[ai_][bj_][m_][n_]), f32x4) * (swv[bj_][n_] * sxr) : acc[ai_][bj_][m_][n_])
        if (pn <= 2) {
            bf16* base = (bf16*)(ws + (pn == 0 ? WS_ZP : pn == 1 ? WS_ZQ : WS_ZKV));
            float* ssp = (float*)(ws + (pn == 1 ? WS_SSQ : WS_SSK));
#pragma unroll
            for (int ai = 0; ai < 2; ++ai)
#pragma unroll
                for (int m = 0; m < 4; ++m) { const int row = row0 + ai * 128 + m * 16; bf16* rowp = base + (size_t)row * 256 + cl; float ss = 0.f; const float sxr = I8 ? sc[row - u.pm * 256] : 1.f;
#pragma unroll
                    for (int bj = 0; bj < 2; ++bj) { const f32x4 v0 = ZV(ai, bj, m, 0), v1 = ZV(ai, bj, m, 1);
                        if (bj == 0 || pn == 1) ss += (v0[0] * v0[0] + v0[1] * v0[1]) + (v0[2] * v0[2] + v0[3] * v0[3]) + (v1[0] * v1[0] + v1[1] * v1[1]) + (v1[2] * v1[2] + v1[3] * v1[3]);
                        u32x4 w; w.x = pk2(v0[0], v0[1]); w.y = pk2(v0[2], v0[3]); w.z = pk2(v1[0], v1[1]); w.w = pk2(v1[2], v1[3]);
                        *(u32x4*)(rowp + bj * 128) = w; }
                    if (pn >= 1) { ss = xsum16(ss); ss = xsum32(ss); if (fq == 0) ssp[(size_t)row * 4 + wc] = ss; }
                    if (pn == 2 && wc == 0) {
                        const f32x4 v0 = ZV(ai, 1, m, 0), v1 = ZV(ai, 1, m, 1); const float x[8] = {v0[0], v0[1], v0[2], v0[3], v1[0], v1[1], v1[2], v1[3]};
                        const float* cs = (const float*)(ws + WS_CS) + (size_t)(row % SEQ) * 32 + 8 * (fq & 1); float r[8];
#pragma unroll
                        for (int j = 0; j < 8; ++j) { const float y = xget32(x[j], fq >= 2); const float c = cs[j], sn = cs[16 + j]; r[j] = (fq < 2) ? (x[j] * c - y * sn) : (x[j] * c + y * sn); }
                        u32x4 w; w.x = pk2(r[0], r[1]); w.y = pk2(r[2], r[3]); w.z = pk2(r[4], r[5]); w.w = pk2(r[6], r[7]);
                        bf16* kfp = (bf16*)(ws + WS_KF) + (size_t)row * 1024 + 64 + 8 * fq;
#pragma unroll
                        for (int hh = 0; hh < 8; ++hh) *(u32x4*)(kfp + hh * 128) = w; } }
        } else if (pn <= 4) {
            bf16* base = (bf16*)(ws + WS_U);
#pragma unroll
            for (int ai = 0; ai < 2; ++ai)
#pragma unroll
                for (int m = 0; m < 4; ++m) { bf16* rowp = base + (size_t)(row0 + ai * 128 + m * 16) * 256 + (pn - 3) * 128 + cl; float r[8]; const float sxr = I8 ? sc[wr * 64 + fr + ai * 128 + m * 16] : 1.f;
#pragma unroll
                    for (int n = 0; n < 2; ++n) { const f32x4 va = ZV(ai, 0, m, n), vg = ZV(ai, 1, m, n);
#pragma unroll
                        for (int k = 0; k < 4; ++k) r[n * 4 + k] = va[k] * sigmoidf_(vg[k]); }
                    u32x4 w; w.x = pk2(r[0], r[1]); w.y = pk2(r[2], r[3]); w.z = pk2(r[4], r[5]); w.w = pk2(r[6], r[7]);
                    *(u32x4*)rowp = w; }
        } else {
            bf16* base = (bf16*)(ws + WS_GS); f32x2* stp = (f32x2*)(ws + WS_STV);
#pragma unroll
            for (int ai = 0; ai < 2; ++ai)
#pragma unroll
                for (int m = 0; m < 4; ++m) { const int row = row0 + ai * 128 + m * 16; bf16* rowp = base + (size_t)row * 512 + (pn - 5) * 256 + cl; float s1 = 0.f, s2 = 0.f; const float sxr = I8 ? sc[row - u.pm * 256] : 1.f;
#pragma unroll
                    for (int bj = 0; bj < 2; ++bj) { const f32x4 v0 = ZV(ai, bj, m, 0), v1 = ZV(ai, bj, m, 1);
                        const f32x2 a = gelu_pk((f32x2){v0[0], v0[1]}), b = gelu_pk((f32x2){v0[2], v0[3]}), c = gelu_pk((f32x2){v1[0], v1[1]}), d = gelu_pk((f32x2){v1[2], v1[3]});
                        s1 += (a.x + a.y) + (b.x + b.y) + (c.x + c.y) + (d.x + d.y); s2 += (a.x * a.x + a.y * a.y) + (b.x * b.x + b.y * b.y) + (c.x * c.x + c.y * c.y) + (d.x * d.x + d.y * d.y);
                        u32x4 w; w.x = pk2(a.x, a.y); w.y = pk2(b.x, b.y); w.z = pk2(c.x, c.y); w.w = pk2(d.x, d.y);
                        *(u32x4*)(rowp + bj * 128) = w; }
                    if (pn == 6) { s1 = xsum16(s1); s1 = xsum32(s1); s2 = xsum16(s2); s2 = xsum32(s2); if (fq == 0) stp[(size_t)row * 4 + wc] = (f32x2){s1, s2}; } }
        }
#undef ZV
    }
};
struct EpiBfScale {
    static constexpr bool PERM = true;
    bf16* O; int ldc; const float* ssq; float inv_n;
    __device__ __forceinline__ void operator()(AccRef acc, const Unit& u, int wr, int wc, int fr, int fq) const {
        const int row0 = u.pm * 256 + wr * 64 + fr, col0 = u.pn * 256 + wc * 32 + 8 * fq;
#pragma unroll
        for (int ai = 0; ai < 2; ++ai)
#pragma unroll
            for (int m = 0; m < 4; ++m) { const int row = row0 + ai * 128 + m * 16; bf16* rowp = O + (size_t)row * ldc + col0;
                const f32x4 p = *(const f32x4*)(ssq + (size_t)row * 4); const float rs = 1.0f / sqrtf(((p[0] + p[1]) + (p[2] + p[3])) * inv_n + EPS);
#pragma unroll
                for (int bj = 0; bj < 2; ++bj) { const f32x4 v0 = acc[ai][bj][m][0] * rs, v1 = acc[ai][bj][m][1] * rs;
                    u32x4 w; w.x = pk2(v0[0], v0[1]); w.y = pk2(v0[2], v0[3]); w.z = pk2(v1[0], v1[1]); w.w = pk2(v1[2], v1[3]);
                    *(u32x4*)(rowp + bj * 128) = w; } }
    }
};
struct EpiQ {
    static constexpr bool PERM = true;
    bf16* O; const float* ssq; const float* CS;
    __device__ __forceinline__ void operator()(AccRef acc, const Unit& u, int wr, int wc, int fr, int fq) const {
        const int row0 = u.pm * 256 + wr * 64 + fr;
        const int cg0 = u.pn * 256 + wc * 32; const bool rope0 = (cg0 % 96) == 64, rope1 = ((cg0 + 128) % 96) == 64;
#pragma unroll
        for (int ai = 0; ai < 2; ++ai) {
          f32x4 pq[4], cq[4][4];
#pragma unroll
          for (int m = 0; m < 4; ++m) pq[m] = *(const f32x4*)(ssq + (size_t)(row0 + ai * 128 + m * 16) * 4);
          if (rope0 || rope1) {
#pragma unroll
            for (int m = 0; m < 4; ++m) { const float* cs = CS + (size_t)((row0 + ai * 128 + m * 16) % SEQ) * 32 + 8 * (fq & 1);
                cq[m][0] = *(const f32x4*)(cs); cq[m][1] = *(const f32x4*)(cs + 4); cq[m][2] = *(const f32x4*)(cs + 16); cq[m][3] = *(const f32x4*)(cs + 20); }
          } else {
#pragma unroll
            for (int m = 0; m < 4; ++m)
#pragma unroll
                for (int q = 0; q < 4; ++q) cq[m][q] = (f32x4){0.f, 0.f, 0.f, 0.f}; }
#pragma unroll
            for (int m = 0; m < 4; ++m) { const int row = row0 + ai * 128 + m * 16;
                const f32x4 p = pq[m]; const float rs = att2::C2 / sqrtf(((p[0] + p[1]) + (p[2] + p[3])) * (1.f / 256.f) + EPS);
                const float cs[32] = {cq[m][0][0], cq[m][0][1], cq[m][0][2], cq[m][0][3], cq[m][1][0], cq[m][1][1], cq[m][1][2], cq[m][1][3], 0.f, 0.f, 0.f, 0.f, 0.f, 0.f, 0.f, 0.f,
                                      cq[m][2][0], cq[m][2][1], cq[m][2][2], cq[m][2][3], cq[m][3][0], cq[m][3][1], cq[m][3][2], cq[m][3][3], 0.f, 0.f, 0.f, 0.f, 0.f, 0.f, 0.f, 0.f};
#pragma unroll
                for (int bj = 0; bj < 2; ++bj) { const int cg = u.pn * 256 + bj * 128 + wc * 32;
                    const f32x4 v0 = acc[ai][bj][m][0] * rs, v1 = acc[ai][bj][m][1] * rs; float x[8] = {v0[0], v0[1], v0[2], v0[3], v1[0], v1[1], v1[2], v1[3]};
                    if (bj == 0 ? rope0 : rope1) {
#pragma unroll
                        for (int j = 0; j < 8; ++j) { const float y = xget32(x[j], fq >= 2); const float c = cs[j], sn = cs[16 + j]; x[j] = (fq < 2) ? (x[j] * c - y * sn) : (x[j] * c + y * sn); } }
                    u32x4 w; w.x = pk2(x[0], x[1]); w.y = pk2(x[2], x[3]); w.z = pk2(x[4], x[5]); w.w = pk2(x[6], x[7]);
                    *(u32x4*)(O + (size_t)row * 768 + cg + 8 * fq) = w; } }
          asm volatile("" ::: "memory"); }
    }
};
struct EpiKV {
    static constexpr bool PERM = true;
    bf16* KF; bf16* VB; const float* ssq;
    __device__ __forceinline__ void operator()(AccRef acc, const Unit& u, int wr, int wc, int fr, int fq) const {
        const int row0 = u.pm * 256 + wr * 64 + fr;
        f32x4 pq[2][4];
#pragma unroll
        for (int ai = 0; ai < 2; ++ai)
#pragma unroll
            for (int m = 0; m < 4; ++m) pq[ai][m] = *(const f32x4*)(ssq + (size_t)(row0 + ai * 128 + m * 16) * 4);
#pragma unroll
        for (int ai = 0; ai < 2; ++ai)
#pragma unroll
            for (int m = 0; m < 4; ++m) { const int row = row0 + ai * 128 + m * 16;
                const f32x4 p = pq[ai][m]; const float rs = 1.0f / sqrtf(((p[0] + p[1]) + (p[2] + p[3])) * (1.f / 128.f) + EPS);
#pragma unroll
                for (int bj = 0; bj < 2; ++bj) { const int hd = 2 * u.pn + bj; const f32x4 v0 = acc[ai][bj][m][0] * rs, v1 = acc[ai][bj][m][1] * rs;
                    u32x4 w; w.x = pk2(v0[0], v0[1]); w.y = pk2(v0[2], v0[3]); w.z = pk2(v1[0], v1[1]); w.w = pk2(v1[2], v1[3]);
                    bf16* dst = (wc < 2) ? (KF + (size_t)row * 1024 + hd * 128 + wc * 32 + 8 * fq) : (VB + (size_t)row * 512 + hd * 64 + (wc - 2) * 32 + 8 * fq);
                    *(u32x4*)dst = w; } }
    }
};
struct EpiBf {
    static constexpr bool PERM = true;
    bf16* O; int ldc; int pm0;
    __device__ __forceinline__ void operator()(AccRef acc, const Unit& u, int wr, int wc, int fr, int fq) const {
        const int row0 = (u.pm - pm0) * 256 + wr * 64 + fr, col0 = u.pn * 256 + wc * 32 + 8 * fq;
#pragma unroll
        for (int ai = 0; ai < 2; ++ai)
#pragma unroll
            for (int m = 0; m < 4; ++m) { bf16* rowp = O + (size_t)(row0 + ai * 128 + m * 16) * ldc + col0;
#pragma unroll
                for (int bj = 0; bj < 2; ++bj) { const f32x4 v0 = acc[ai][bj][m][0], v1 = acc[ai][bj][m][1];
                    u32x4 w; w.x = pk2(v0[0], v0[1]); w.y = pk2(v0[2], v0[3]); w.z = pk2(v1[0], v1[1]); w.w = pk2(v1[2], v1[3]);
                    *(u32x4*)(rowp + bj * 128) = w; } }
    }
};
struct EpiMoeDown {
    static constexpr bool PERM = true;
    bf16* Y; float* YF;
    __device__ __forceinline__ void operator()(AccRef acc, const Unit& u, int wr, int wc, int fr_, int fq_) const {
        int ln_ = lane_id(); asm volatile("" : "+v"(ln_)); const int fr = ln_ & 15, fq = ln_ >> 4; (void)fr_; (void)fq_;
        const int row0 = u.pm * 256 + wr * 64 + fr, col0 = u.pn * 256 + wc * 32 + 8 * fq; constexpr float UNS = 1.0f / (F8_SH * F8_SW);
        if (u.aux == 0) {
#pragma unroll
            for (int ai = 0; ai < 2; ++ai)
#pragma unroll
                for (int m = 0; m < 4; ++m) { unsigned char* rowp = (unsigned char*)Y + (size_t)(row0 + ai * 128 + m * 16) * DM + col0;
#pragma unroll
                    for (int bj = 0; bj < 2; ++bj) { const f32x4 v0 = acc[ai][bj][m][0] * (UNS * F8_SY), v1 = acc[ai][bj][m][1] * (UNS * F8_SY);
                        *(v2u*)(rowp + bj * 128) = (v2u){f8x4(v0[0], v0[1], v0[2], v0[3]), f8x4(v1[0], v1[1], v1[2], v1[3])}; } }
        } else {
            float* slab = YF + (size_t)(u.aux - 1) * (8 * 256 * DM);
#pragma unroll
            for (int ai = 0; ai < 2; ++ai)
#pragma unroll
                for (int m = 0; m < 4; ++m) { float* rowp = slab + (size_t)(row0 - 32768 + ai * 128 + m * 16) * DM + col0;
#pragma unroll
                    for (int bj = 0; bj < 2; ++bj) { *(f32x4*)(rowp + bj * 128) = acc[ai][bj][m][0] * UNS; *(f32x4*)(rowp + bj * 128 + 4) = acc[ai][bj][m][1] * UNS; } }
        }
    }
};
template <bool I8, bool F8OUT = false, bool F8IN = false> struct EpiSwiGLUT {
    static constexpr bool PERM = true;
    bf16* H; int ldc; int pm0; const float* sx; const float* sw;
    __device__ __forceinline__ const float* pf_ptr(const Unit& u, int w) const { return w == 0 ? sx + u.pm * 256 : sw + (size_t)u.aux * 7168 + u.pn * 256; }
    __device__ __forceinline__ void operator()(AccRef acc, const Unit& u, int wr, int wc, int fr, int fq) const { body(acc, u, wr, wc, fr, fq, nullptr); }
    __device__ __forceinline__ void operator()(AccRef acc, const Unit& u, int wr, int wc, int fr, int fq, const LAS float* sc) const { body(acc, u, wr, wc, fr, fq, sc); }
    __device__ __forceinline__ void body(AccRef acc, const Unit& u, int wr, int wc, int fr, int fq, const LAS float* sc) const {
        const int row0 = (u.pm - pm0) * 256 + wr * 64 + fr, col0 = u.pn * 128 + wc * 32 + 8 * fq;
        f32x4 sg[2], su[2];
        if (I8) {
#pragma unroll
            for (int n = 0; n < 2; ++n) { sg[n] = *(const LAS f32x4*)(sc + 256 + wc * 32 + 8 * fq + 4 * n); su[n] = *(const LAS f32x4*)(sc + 256 + 128 + wc * 32 + 8 * fq + 4 * n); } }
#pragma unroll
        for (int ai = 0; ai < 2; ++ai)
#pragma unroll
            for (int m = 0; m < 4; ++m) { bf16* rowp = H + (size_t)(row0 + ai * 128 + m * 16) * ldc + col0;
                unsigned char* rowp8 = (unsigned char*)H + (size_t)(row0 + ai * 128 + m * 16) * ldc + col0; (void)rowp8; (void)rowp;
                float r[8]; const float sxr = I8 ? sc[wr * 64 + fr + ai * 128 + m * 16] : 1.f;
#pragma unroll
                for (int n = 0; n < 2; ++n)
#pragma unroll
                    for (int k = 0; k < 4; ++k) {
                        float gq, up;
                        if (I8) { gq = (float)__builtin_bit_cast(pg8::i32x4, acc[ai][0][m][n])[k] * (sxr * sg[n][k]); up = (float)__builtin_bit_cast(pg8::i32x4, acc[ai][1][m][n])[k] * (sxr * su[n][k]); }
                        else if (F8IN && F8OUT) { constexpr float C8 = 1.0f / (F8_SA * F8_SWU);
                            const float ag = acc[ai][0][m][n][k], au = acc[ai][1][m][n][k];
                            r[n * 4 + k] = (ag * au) * (C8 * C8 * F8_SH) * __builtin_amdgcn_rcpf(1.0f + __builtin_amdgcn_exp2f(ag * (-1.4426950408889634f * C8))); continue; }
                        else { constexpr float C8 = F8IN ? 1.0f / (F8_SA * F8_SWU) : 1.0f; gq = acc[ai][0][m][n][k] * C8; up = acc[ai][1][m][n][k] * C8; }
                        r[n * 4 + k] = gq * sigmoidf_(gq) * up; }
                if constexpr (F8OUT) { constexpr float SO = (F8IN && F8OUT) ? 1.0f : F8_SH;
                    *(v2u*)rowp8 = (v2u){f8x4(r[0] * SO, r[1] * SO, r[2] * SO, r[3] * SO), f8x4(r[4] * SO, r[5] * SO, r[6] * SO, r[7] * SO)}; }
                else { u32x4 w; w.x = pk2(r[0], r[1]); w.y = pk2(r[2], r[3]); w.z = pk2(r[4], r[5]); w.w = pk2(r[6], r[7]);
                *(u32x4*)rowp = w; } }
    }
};
typedef EpiSwiGLUT<false> EpiSwiGLU;
template <class TB> struct EpiResB {
    static constexpr bool PERM = true;
    const TB* base; bf16* out;
    __device__ __forceinline__ void operator()(AccRef acc, const Unit& u, int wr, int wc, int fr, int fq) const {
        const int row0 = u.pm * 256 + wr * 64 + fr, col0 = u.pn * 256 + wc * 32 + 8 * fq;
#pragma unroll
        for (int ai = 0; ai < 2; ++ai) {
            f32x4 b[4][2][2];
#pragma unroll
            for (int m = 0; m < 4; ++m)
#pragma unroll
                for (int bj = 0; bj < 2; ++bj) { const size_t off = (size_t)(row0 + ai * 128 + m * 16) * DM + col0 + bj * 128;
                    if constexpr (sizeof(TB) == 4) { b[m][bj][0] = *(const f32x4*)((const float*)base + off); b[m][bj][1] = *(const f32x4*)((const float*)base + off + 4); }
                    else { const u32x4 z = *(const u32x4*)((const bf16*)base + off); b[m][bj][0] = __builtin_bit_cast(f32x4, z); } }
#pragma unroll
            for (int m = 0; m < 4; ++m)
#pragma unroll
                for (int bj = 0; bj < 2; ++bj) { const size_t off = (size_t)(row0 + ai * 128 + m * 16) * DM + col0 + bj * 128; f32x4 v0, v1;
                    if constexpr (sizeof(TB) == 4) { v0 = b[m][bj][0]; v1 = b[m][bj][1]; }
                    else { const u32x4 z = __builtin_bit_cast(u32x4, b[m][bj][0]); v0 = (f32x4){bflo(z.x), bfhi(z.x), bflo(z.y), bfhi(z.y)}; v1 = (f32x4){bflo(z.z), bfhi(z.z), bflo(z.w), bfhi(z.w)}; }
                    v0 += acc[ai][bj][m][0]; v1 += acc[ai][bj][m][1];
                    u32x4 w; w.x = pk2(v0[0], v0[1]); w.y = pk2(v0[2], v0[3]); w.z = pk2(v1[0], v1[1]); w.w = pk2(v1[2], v1[3]);
                    *(u32x4*)(out + off) = w; }
            asm volatile("" ::: "memory"); }
    }
};
__device__ __forceinline__ u32x4 ld16_sc1(const void* p) { const unsigned long long a = __hip_atomic_load((const unsigned long long*)p, __ATOMIC_RELAXED, __HIP_MEMORY_SCOPE_AGENT), b = __hip_atomic_load((const unsigned long long*)p + 1, __ATOMIC_RELAXED, __HIP_MEMORY_SCOPE_AGENT); return (u32x4){(unsigned)a, (unsigned)(a >> 32), (unsigned)b, (unsigned)(b >> 32)}; }
struct EpiGate {
    static constexpr bool PERM = true;
    bf16* TG; const float* bg; bf16* MG; const float* sx; const float* sw;
    __device__ static __forceinline__ bool unit_i8(const Unit& u) { return GATE_I8 && (u.aux & 1) == 0; }
    __device__ __forceinline__ const float* pf_ptr(const Unit& u, int w) const { if (u.aux & 1) return nullptr; return w == 0 ? sx + u.pm * 256 : sw + (u.aux >> 1) * 1024 + u.pn * 256; }
    __device__ __forceinline__ void operator()(AccRef acc, const Unit& u, int wr, int wc, int fr_, int fq_, const LAS float* sc, unsigned (&tg)[32]) const {
        int ln_ = lane_id(); asm volatile("" : "+v"(ln_)); const int fr = ln_ & 15, fq = ln_ >> 4; (void)fr_; (void)fq_;
        const int br = u.aux >> 1, kind = u.aux & 1; const int lr0 = wr * 64 + fr, lc0 = wc * 32 + 8 * fq;
        if (kind == 0) {
            constexpr float NL2E = -1.4426950408889634f, I255 = 1.f / 255.f;
            f32x4 bb[2][2];
#pragma unroll
            for (int bj = 0; bj < 2; ++bj)
#pragma unroll
                for (int n = 0; n < 2; ++n) bb[bj][n] = *(const f32x4*)(bg + br * 1024 + u.pn * 256 + lc0 + bj * 128 + 4 * n);
#pragma unroll
            for (int bj = 0; bj < 2; ++bj)
#pragma unroll
                for (int n = 0; n < 2; ++n) {
                    const f32x4 b0 = bb[bj][n] * NL2E, w0 = *(const LAS f32x4*)(sc + 256 + lc0 + bj * 128 + 4 * n) * NL2E;
#pragma unroll
                    for (int ai = 0; ai < 2; ++ai)
#pragma unroll
                        for (int m = 0; m < 4; ++m) { const int lr = lr0 + ai * 128 + m * 16; const float sxr = sc[lr];
                            const pg8::i32x4 a0 = __builtin_bit_cast(pg8::i32x4, acc[ai][bj][m][n]); unsigned q = 0u;
#pragma unroll
                            for (int k = 0; k < 4; ++k) { const float zz = GATE_I8 ? __builtin_fmaf((float)a0[k], sxr * w0[k], b0[k]) : __builtin_fmaf(acc[ai][bj][m][n][k], NL2E, b0[k]);
                                const float r = __builtin_amdgcn_rcpf(__builtin_fmaf(__builtin_amdgcn_exp2f(zz), I255, I255));
                                q = __builtin_amdgcn_cvt_pk_u8_f32(__builtin_rintf(r), k, q); }
                            tg[((ai * 2 + bj) * 4 + m) * 2 + n] = q; } }
        } else {
#pragma unroll
            for (int ai = 0; ai < 2; ++ai) {
                u32x4 pp[4][2];
                if (br > 0) {
#pragma unroll
                    for (int m = 0; m < 4; ++m) { const int lr = lr0 + ai * 128 + m * 16; const bf16* mp = MG + (size_t)(u.pm * 256 + lr) * DM + u.pn * 256 + lc0;
#pragma unroll
                        for (int bj = 0; bj < 2; ++bj) pp[m][bj] = *(const u32x4*)(mp + bj * 128); }
                } else {
#pragma unroll
                    for (int m = 0; m < 4; ++m)
#pragma unroll
                        for (int bj = 0; bj < 2; ++bj) pp[m][bj] = (u32x4){0u, 0u, 0u, 0u}; }
#pragma unroll
                for (int m = 0; m < 4; ++m) { const int lr = lr0 + ai * 128 + m * 16; bf16* mp = MG + (size_t)(u.pm * 256 + lr) * DM + u.pn * 256 + lc0;
#pragma unroll
                    for (int bj = 0; bj < 2; ++bj) {
                        const unsigned z0 = tg[((ai * 2 + bj) * 4 + m) * 2 + 0], z1 = tg[((ai * 2 + bj) * 4 + m) * 2 + 1]; constexpr float I255 = 1.f / 255.f;
                        float gt[8] = {(float)(z0 & 0xffu) * I255, (float)((z0 >> 8) & 0xffu) * I255, (float)((z0 >> 16) & 0xffu) * I255, (float)(z0 >> 24) * I255,
                                       (float)(z1 & 0xffu) * I255, (float)((z1 >> 8) & 0xffu) * I255, (float)((z1 >> 16) & 0xffu) * I255, (float)(z1 >> 24) * I255}; float r[8];
#pragma unroll
                        for (int n = 0; n < 2; ++n)
#pragma unroll
                            for (int k = 0; k < 4; ++k) r[n * 4 + k] = gt[n * 4 + k]
                                * acc[ai][bj][m][n][k]
                                ;
                        { const u32x4 p = pp[m][bj];
                            r[0] += bflo(p.x); r[1] += bfhi(p.x); r[2] += bflo(p.y); r[3] += bfhi(p.y); r[4] += bflo(p.z); r[5] += bfhi(p.z); r[6] += bflo(p.w); r[7] += bfhi(p.w); }
                        u32x4 w; w.x = pk2(r[0], r[1]); w.y = pk2(r[2], r[3]); w.z = pk2(r[4], r[5]); w.w = pk2(r[6], r[7]);
                        *(u32x4*)(mp + bj * 128) = w; } }
                asm volatile("" ::: "memory"); }
        }
    }
};

struct Frame {
    LAS unsigned char* lds; volatile LAS unsigned* MISC; gu32* ctl;
    int wave, G, gw, NGW;
    unsigned char* ws;
};
struct Args { const float* in[33]; float* out; unsigned char* ws; int ph_lo, ph_hi, li, pad; };

__device__ __forceinline__ void tr_item(const float* W, int srcld, int n_begin, int nblk, bf16* WT, int dstld, int drow0, int dcol0, int blk, int blkstride, const float* ks,
                                        LAS float* scr, int item, int lane) {
    const int kb = item / nblk, nb = item % nblk, k0 = 64 * kb, n0l = 32 * nb, n0 = n_begin + n0l;
    const int drow = drow0 + (n0l / blk) * blkstride + (n0l % blk);
    float wv_[32];
#pragma unroll
    for (int i = 0; i < 32; ++i) { const int kk = 2 * i + (lane >> 5); wv_[i] = __builtin_nontemporal_load(&W[(size_t)(k0 + kk) * srcld + n0 + (lane & 31)]); }
#pragma unroll
    for (int i = 0; i < 32; ++i) { const int kk = 2 * i + (lane >> 5); const float sc = ks ? ks[k0 + kk] : 1.0f; scr[kk * 33 + (lane & 31)] = wv_[i] * sc; }
    LDS_WAIT(); asm volatile("" ::: "memory");
    const int c = lane & 7;
#pragma unroll
    for (int j = 0; j < 4; ++j) { const int n = (lane >> 3) + 8 * j; const LAS float* s = scr + (8 * c) * 33 + n;
        v4u o; o.x = pk2(s[0 * 33], s[1 * 33]); o.y = pk2(s[2 * 33], s[3 * 33]); o.z = pk2(s[4 * 33], s[5 * 33]); o.w = pk2(s[6 * 33], s[7 * 33]);
        *(GAS v4u*)(WT + (size_t)(drow + n) * dstld + dcol0 + k0 + 8 * c) = o; }
    LDS_WAIT(); asm volatile("" ::: "memory");
}
__device__ __forceinline__ void tr_item_f8(const float* W, int srcld, int nblk, unsigned char* WT8, int dstld, LAS float* scr, int item, int lane) {
    const int kb = item / nblk, nb = item % nblk, k0 = 64 * kb, n0 = 32 * nb;
    float wv_[32];
#pragma unroll
    for (int i = 0; i < 32; ++i) { const int kk = 2 * i + (lane >> 5); wv_[i] = __builtin_nontemporal_load(&W[(size_t)(k0 + kk) * srcld + n0 + (lane & 31)]); }
#pragma unroll
    for (int i = 0; i < 32; ++i) { const int kk = 2 * i + (lane >> 5); scr[kk * 33 + (lane & 31)] = wv_[i] * F8_SW; }
    LDS_WAIT(); asm volatile("" ::: "memory");
    const int c = lane & 7;
#pragma unroll
    for (int j = 0; j < 4; ++j) { const int n = (lane >> 3) + 8 * j; const LAS float* s = scr + (8 * c) * 33 + n;
        *(GAS v2u*)(WT8 + (size_t)(n0 + n) * dstld + k0 + 8 * c) = (v2u){f8x4(s[0 * 33], s[1 * 33], s[2 * 33], s[3 * 33]), f8x4(s[4 * 33], s[5 * 33], s[6 * 33], s[7 * 33])}; }
    LDS_WAIT(); asm volatile("" ::: "memory");
}
__device__ __forceinline__ void poolfold_item(const float* w_in, const float* wp, const float* psc, bf16* WT, LAS float* scr, int item, int lane) {
    const int kb = item >> 2, g = item & 3, k0 = 16 * kb;
#pragma unroll
    for (int k = 0; k < 16; ++k) scr[k * 64 + lane] = w_in[(size_t)(k0 + k) * D_IN + g * 64 + lane];
    float wc[64];
#pragma unroll
    for (int c = 0; c < 64; ++c) wc[c] = wp[(size_t)(g * 64 + c) * 64 + lane];
    const float sc = psc[g * 64 + lane];
    LDS_WAIT(); asm volatile("" ::: "memory");
    bf16* orow = WT + (size_t)(g * 64 + lane) * XLD + k0;
#pragma unroll 1
    for (int k8 = 0; k8 < 2; ++k8) { float r[8];
#pragma unroll
        for (int kk = 0; kk < 8; ++kk) { float a = 0.f; const LAS float* sp = scr + (k8 * 8 + kk) * 64;
#pragma unroll
            for (int c = 0; c < 64; ++c) a += sp[c] * wc[c];
            r[kk] = a * sc; }
        *(GAS v4u*)(orow + k8 * 8) = (v4u){pk2(r[0], r[1]), pk2(r[2], r[3]), pk2(r[4], r[5]), pk2(r[6], r[7])}; }
    LDS_WAIT(); asm volatile("" ::: "memory");
}
__device__ const double ROPE_INV[16] = {1.0, 0.5623413251903491, 0.31622776601683794, 0.1778279410038923, 0.1, 0.05623413251903491, 0.03162277660168379, 0.01778279410038923,
                                        0.01, 0.005623413251903491, 0.0031622776601683794, 0.0017782794100389228, 0.001, 0.0005623413251903491, 0.00031622776601683794, 0.00017782794100389227};

__device__ __forceinline__ void panel_load(const float* W, int n0, int w, int lane, float (&wv)[64]) {
    const float* p = W + (size_t)(w * 128 + (lane >> 5)) * DFFE + n0 + (lane & 31);
#pragma unroll
    for (int i = 0; i < 64; ++i) wv[i] = __builtin_nontemporal_load(p + (size_t)(2 * i) * DFFE);
}
__device__ __forceinline__ void p_moe_panels(Frame& F, const Args& a) {
    constexpr int NIT = NEXP * 2 * (DFFE / 32);
    const int lane = lane_id(), w = F.wave, G = F.G;
    LAS float* scr = (LAS float*)F.lds; LAS float* cmax = (LAS float*)(F.lds + SC_LDS_OFF);
    unsigned char* ws = F.ws;
    float wv[64];
    int item = (int)blockIdx.x;
#define PANEL_SRC(it_) (a.in[29 + (((it_) % 224) / 112)] + (size_t)((it_) / 224) * DM * DFFE)
    if (item < NIT) panel_load(PANEL_SRC(item), 32 * (item % 112), w, lane, wv);
    for (; item < NIT; item += G) {
        const int e = item / 224, isup = (item % 224) / 112, nb = item % 112;
        float am = 0.f;
#if !MOE_UP_F8
#pragma unroll
        for (int i = 0; i < 64; ++i) am = fmaxf(am, fabsf(wv[i]));
        am = fmaxf(am, __shfl_xor(am, 32));
#endif
#pragma unroll
        for (int i = 0; i < 64; ++i) { const int k = w * 128 + 2 * i + (lane >> 5); scr[k * 32 + (((lane & 31) + (k >> 4)) & 31)] = wv[i]; }
        if (lane < 32) cmax[w * 32 + lane] = am;
        asm volatile("s_waitcnt lgkmcnt(0)\n\ts_barrier" ::: "memory");
        const int nxt = item + G;
        if (nxt < NIT) panel_load(PANEL_SRC(nxt), 32 * (nxt % 112), w, lane, wv);
        const int drow0 = isup * 128 + (nb >> 2) * 256 + (nb & 3) * 32;
        unsigned char* dst = ws + WS_MGU + (size_t)e * SZ_MGU8; float* swp = (float*)(ws + WS_SWMOE) + e * (2 * DFFE);
#pragma unroll
        for (int i = 0; i < 4; ++i) { const int n = 4 * w + i;
            float amn = cmax[n];
#pragma unroll
            for (int ww = 1; ww < 8; ++ww) amn = fmaxf(amn, cmax[ww * 32 + n]);
            const float sc = amn > 0.f ? amn * (1.f / 127.f) : 1.f, inv = amn > 0.f ? 127.f / amn : 0.f;
            const LAS float* sp = scr + (16 * lane) * 32 + ((n + lane) & 31);
            float x[16];
#pragma unroll
            for (int j = 0; j < 16; ++j) x[j] = sp[j * 32];
#if MOE_UP_F8
            const v4u q = (v4u){f8x4(x[0] * F8_SWU, x[1] * F8_SWU, x[2] * F8_SWU, x[3] * F8_SWU), f8x4(x[4] * F8_SWU, x[5] * F8_SWU, x[6] * F8_SWU, x[7] * F8_SWU), f8x4(x[8] * F8_SWU, x[9] * F8_SWU, x[10] * F8_SWU, x[11] * F8_SWU), f8x4(x[12] * F8_SWU, x[13] * F8_SWU, x[14] * F8_SWU, x[15] * F8_SWU)}; (void)inv;
#else
            const v4u q = (v4u){q8x4(x[0], x[1], x[2], x[3], inv), q8x4(x[4], x[5], x[6], x[7], inv), q8x4(x[8], x[9], x[10], x[11], inv), q8x4(x[12], x[13], x[14], x[15], inv)};
#endif
            *(v4u*)(dst + (size_t)(drow0 + n) * DM + 16 * lane) = q; if (lane == 0) swp[drow0 + n] = sc; }
        asm volatile("s_waitcnt lgkmcnt(0)\n\ts_barrier" ::: "memory");
    }
#undef PANEL_SRC
}
__device__ __forceinline__ void p_prologue(Frame& F, const Args& a) {
    const int lane_v = lane_id(), tid_v = F.wave * 64 + lane_v; (void)tid_v;
    LAS float* scr = (LAS float*)(F.lds + F.wave * 16384);
    unsigned char* ws = F.ws;
    p_moe_panels(F, a);
    int it = F.gw;
    const int NGW = F.NGW;
#define JOB(src, K_, srcld, nbeg, ncnt, dst, dstld, drow0, dcol0, blk, blkstride, ks) do { const int nblk_ = (ncnt) / 32, nit_ = ((K_) / 64) * nblk_; \
        for (; it < nit_; it += NGW) tr_item((src), (srcld), (nbeg), nblk_, (dst), (dstld), (drow0), (dcol0), (blk), (blkstride), (ks), scr, it, lane_v); it -= nit_; } while (0)
    for (int l = 0; l < 2; ++l) {
        const float* w_in = a.in[2] + (size_t)l * DM * D_IN; bf16* win_t = (bf16*)(ws + WS_WIN + l * SZ_WIN);
        { const int nit_ = 64 * 4; for (; it < nit_; it += NGW) poolfold_item(w_in, a.in[4] + (size_t)l * 4 * 64 * 64, a.in[5] + l * 256, win_t, scr, it, lane_v); it -= nit_; }
        JOB(w_in, DM, D_IN, 256, 416, win_t, XLD, 256, 0, 416, 0, nullptr);
        JOB(w_in, DM, D_IN, 672, 256, win_t, XLD, 768, 0, 128, 256, nullptr);
        JOB(w_in, DM, D_IN, 928, 256, win_t, XLD, 896, 0, 128, 256, nullptr);
        JOB(w_in, DM, D_IN, 1184, 4608, win_t, XLD, 1280, 0, 4608, 0, nullptr);
        bf16* wcat = (bf16*)(ws + WS_WCAT + l * SZ_WCAT);
        JOB(a.in[6] + (size_t)l * 256 * DM, 256, DM, 0, DM, wcat, KCAT, 0, F_POOL, DM, 0, nullptr);
        JOB(a.in[11] + (size_t)l * 512 * DM, 512, DM, 0, DM, wcat, KCAT, 0, F_MLA, DM, 0, nullptr);
        JOB(a.in[16] + (size_t)l * 256 * DM, 256, DM, 0, DM, wcat, KCAT, 0, F_CONV, DM, 0, nullptr);
        JOB(a.in[21] + (size_t)l * 256 * DM, 256, DM, 0, DM, wcat, KCAT, 0, F_SGU, DM, 0, nullptr);
        JOB(a.in[22] + (size_t)l * DM * DM, DM, DM, 0, DM, (bf16*)(ws + WS_WO + l * SZ_WO), DM, 0, 0, DM, 0, nullptr);
        JOB(a.in[8] + (size_t)l * 256 * 768, 256, 768, 0, 768, (bf16*)(ws + WS_WUQ + l * SZ_WUQ), 256, 0, 0, 768, 0, a.in[7] + l * 256);
        JOB(a.in[10] + (size_t)l * 128 * 1024, 128, 1024, 0, 1024, (bf16*)(ws + WS_WUKV + l * SZ_WUKV), 256, 0, 0, 1024, 0, a.in[9] + l * 128);
    }
    JOB(a.in[24], DM, DFF, 0, DFF, (bf16*)(ws + WS_WGU0), DM, 0, 0, 128, 256, nullptr);
    JOB(a.in[25], DM, DFF, 0, DFF, (bf16*)(ws + WS_WGU0), DM, 128, 0, 128, 256, nullptr);
    JOB(a.in[26], DFF, DM, 0, DM, (bf16*)(ws + WS_WD0), DFF, 0, 0, DM, 0, nullptr);
#ifndef PROBE_PRO
#define PROBE_PRO 0
#endif
    for (int rp_ = 0; rp_ < 1 + PROBE_PRO; ++rp_)
    for (int e = 0; e < NEXP; ++e) {
        { const int nblk_ = DM / 32, nit_ = (DFFE / 64) * nblk_;
          for (; it < nit_; it += NGW) tr_item_f8(a.in[31] + (size_t)e * DFFE * DM, DM, nblk_, ws + WS_MD + (size_t)e * (SZ_MD / 2), DFFE, scr, it, lane_v); it -= nit_; }
    }
#undef JOB
    const int gt = F.gw * 64 + lane_v, NT = NGW * 64;
    for (int i = gt; i < 2 * 96 * (DM / 8); i += NT) { const int l = i / (96 * 128), r = (i / 128) % 96, c = i % 128;
        *(GAS v4u*)((bf16*)(ws + WS_WIN + l * SZ_WIN) + (size_t)(672 + r) * XLD + c * 8) = (v4u){0u, 0u, 0u, 0u}; }
    for (int i = gt; i < 2 * 1024 * 16; i += NT) { const int l = i / (1024 * 16), r = (i / 16) % 1024, c = i % 16;
        *(GAS v4u*)((bf16*)(ws + WS_WUKV + l * SZ_WUKV) + (size_t)r * 256 + 128 + c * 8) = (v4u){0u, 0u, 0u, 0u}; }
    float* cs = (float*)(ws + WS_CS);
    for (int i = gt; i < SEQ * 16; i += NT) { const int pos = i >> 4, k = i & 15; const double ang = (double)pos * ROPE_INV[k];
        double sn_, cn_; sincos(ang, &sn_, &cn_); cs[pos * 32 + k] = (float)cn_; cs[pos * 32 + 16 + k] = (float)sn_; }
}

template <bool ROUTER, bool Q8 = false, bool XB = false>
__device__ __forceinline__ void p_norm(Frame& F, const float* xin, const float* g, bf16* XN, const float* w_router, const float* b_router, float* SX = nullptr) {
    const int lane_v = lane_id(), tid_v = F.wave * 64 + lane_v; (void)tid_v;
    int lane_ = lane_v; asm volatile("" : "+v"(lane_));
    const GAS f32x4* gp = (const GAS f32x4*)g + lane_;
    f32x4 gv[4];
#pragma unroll
    for (int j = 0; j < 4; ++j) gv[j] = gp[64 * j];
    LAS int* lcnt = (LAS int*)(F.lds);
    int* tok_e = (int*)(F.ws + WS_TOK); int* tok_p = tok_e + 2 * M; float* tok_w = (float*)(tok_p + 2 * M);
    if (ROUTER) { if (tid_v < 16) lcnt[tid_v] = 0; __syncthreads(); }
    constexpr int NRF = ROUTER ? 2 : 4;
    for (int m0 = F.gw; m0 < M; m0 += NRF * F.NGW) {
      f32x4 vv[NRF][4];
#pragma unroll
      for (int r = 0; r < NRF; ++r) { const int mr = m0 + r * F.NGW;
        if constexpr (XB) { const GAS v2u* xr = (const GAS v2u*)((const bf16*)xin + (size_t)(mr < M ? mr : m0) * DM) + lane_v;
#pragma unroll
            for (int j = 0; j < 4; ++j) { const v2u z = xr[64 * j]; vv[r][j] = (f32x4){bflo(z.x), bfhi(z.x), bflo(z.y), bfhi(z.y)}; } }
        else { const GAS f32x4* xr = (const GAS f32x4*)(xin + (size_t)(mr < M ? mr : m0) * DM) + lane_v;
#pragma unroll
            for (int j = 0; j < 4; ++j) vv[r][j] = xr[64 * j]; } }
#pragma unroll
      for (int r = 0; r < NRF; ++r) { const int m = m0 + r * F.NGW; if (m < M) {
        f32x4 v[4]; float s = 0.f;
#pragma unroll
        for (int j = 0; j < 4; ++j) { v[j] = vv[r][j]; s += (v[j].x * v[j].x + v[j].y * v[j].y) + (v[j].z * v[j].z + v[j].w * v[j].w); }
        const float rs = 1.0f / sqrtf(wave_sum(s) * (1.f / DM) + EPS);
#pragma unroll
        for (int j = 0; j < 4; ++j) v[j] = v[j] * rs * gv[j];
        if (Q8 && ROUTER && MOE_UP_F8) {
            GAS unsigned* o4 = (GAS unsigned*)((unsigned char*)XN + (size_t)m * XLD * 2) + lane_v;
#pragma unroll
            for (int j = 0; j < 4; ++j) o4[64 * j] = f8x4(v[j].x * F8_SA, v[j].y * F8_SA, v[j].z * F8_SA, v[j].w * F8_SA);
        } else if (Q8) {
            float am = 0.f;
#pragma unroll
            for (int j = 0; j < 4; ++j) am = fmaxf(fmaxf(am, fmaxf(fabsf(v[j].x), fabsf(v[j].y))), fmaxf(fabsf(v[j].z), fabsf(v[j].w)));
            am = wave_max(am); const float inv = am > 0.f ? 127.f / am : 0.f;
            GAS unsigned* o4 = (GAS unsigned*)((unsigned char*)XN + (size_t)m * XLD * 2) + lane_v;
#pragma unroll
            for (int j = 0; j < 4; ++j) o4[64 * j] = (ROUTER && MOE_UP_F8) ? f8x4(v[j].x * F8_SA, v[j].y * F8_SA, v[j].z * F8_SA, v[j].w * F8_SA) : q8x4(v[j].x, v[j].y, v[j].z, v[j].w, inv);
            if (lane_v == 0) SX[m] = am > 0.f ? am * (1.f / 127.f) : 1.f;
        } else {
        GAS v2u* o8 = (GAS v2u*)(XN + (size_t)m * XLD) + lane_v;
#pragma unroll
        for (int j = 0; j < 4; ++j) o8[64 * j] = (v2u){pk2(v[j].x, v[j].y), pk2(v[j].z, v[j].w)};
        }
        if (ROUTER) {
            float lg[8];
#pragma unroll
            for (int e = 0; e < 8; ++e) lg[e] = 0.f;
#pragma unroll
            for (int j = 0; j < 4; ++j)
#pragma unroll
                for (int k = 0; k < 4; ++k) { const int col = 4 * lane_v + 256 * j + k; const f32x4 w0 = *(const f32x4*)(w_router + (size_t)col * 8), w1 = *(const f32x4*)(w_router + (size_t)col * 8 + 4);
                    const float hv = v[j][k];
                    lg[0] += hv * w0.x; lg[1] += hv * w0.y; lg[2] += hv * w0.z; lg[3] += hv * w0.w; lg[4] += hv * w1.x; lg[5] += hv * w1.y; lg[6] += hv * w1.z; lg[7] += hv * w1.w; }
#pragma unroll
            for (int e = 0; e < 8; ++e) lg[e] = wave_sum(lg[e]) + b_router[e];
            int e0 = 0; float v0 = lg[0];
#pragma unroll
            for (int e = 1; e < 8; ++e) if (lg[e] > v0) { v0 = lg[e]; e0 = e; }
            int e1 = -1; float v1 = -3.0e38f;
#pragma unroll
            for (int e = 0; e < 8; ++e) if (e != e0 && lg[e] > v1) { v1 = lg[e]; e1 = e; }
            const float ex = expf(v1 - v0), w0 = 1.0f / (1.0f + ex), w1 = ex / (1.0f + ex);
            if (lane_v == 0) { const int p0 = __hip_atomic_fetch_add(lcnt + e0, 1, __ATOMIC_RELAXED, __HIP_MEMORY_SCOPE_WORKGROUP), p1 = __hip_atomic_fetch_add(lcnt + e1, 1, __ATOMIC_RELAXED, __HIP_MEMORY_SCOPE_WORKGROUP);
                tok_e[2 * m] = e0; tok_e[2 * m + 1] = e1; tok_p[2 * m] = p0; tok_p[2 * m + 1] = p1; tok_w[2 * m] = w0; tok_w[2 * m + 1] = w1; }
        }
      } }
    }
    if (ROUTER) {
        VM_WAIT(); __syncthreads();
        if (tid_v < 8) lcnt[8 + tid_v] = (int)__hip_atomic_fetch_add((unsigned*)(F.ctl + CW_MOE + 64 * tid_v), (unsigned)lcnt[tid_v], RLX_AGENT);
        __syncthreads();
        { int* tix = (int*)(F.ws + WS_TIX);
            for (int m = F.gw + lane_v * F.NGW; m < M; m += 64 * F.NGW) { const int e0 = tok_e[2 * m], e1 = tok_e[2 * m + 1]; const int q0 = tok_p[2 * m] + lcnt[8 + e0], q1 = tok_p[2 * m + 1] + lcnt[8 + e1];
                tok_p[2 * m] = q0; tok_p[2 * m + 1] = q1; tix[(size_t)e0 * M + q0] = m; tix[(size_t)e1 * M + q1] = m; } }
        __syncthreads();
    }
}

__device__ __forceinline__ void p_thin(Frame& F, const Args& a, int l) {
    const int lane_v = lane_id(), tid_v = F.wave * 64 + lane_v; (void)tid_v;
    unsigned char* ws = F.ws;
    const bf16* ZP = (const bf16*)(ws + WS_ZP); const bf16* U = (const bf16*)(ws + WS_U); const bf16* GS = (const bf16*)(ws + WS_GS);
    bf16* Fb = (bf16*)(ws + WS_F);
    const int tid = tid_v, lane = lane_v, wave = F.wave;
    {
        const int gt = F.gw * 64 + lane, NT = F.NGW * 64;
        for (int task0 = gt; task0 < M * 32; task0 += 2 * NT) {
            v4u vw[2][16]; int cntv[2];
#pragma unroll
            for (int q = 0; q < 2; ++q) { const int tq = task0 + q * NT, task = tq < M * 32 ? tq : task0; const int m = task >> 5, ch = task & 31, pos = m % SEQ, w = 2 << (ch >> 3); const int cnt = (pos + 1 < w) ? pos + 1 : w; cntv[q] = cnt;
#pragma unroll
                for (int j = 0; j < 16; ++j) vw[q][j] = *(const v4u*)(ZP + (size_t)(m - (j < cnt ? j : 0)) * 256 + ch * 8); }
#pragma unroll
            for (int q = 0; q < 2; ++q) { const int task = task0 + q * NT; if (task < M * 32) { const int m = task >> 5, ch = task & 31, cnt = cntv[q];
                float s[8], c0[8];
#pragma unroll
                for (int k = 0; k < 8; ++k) s[k] = 0.f;
#pragma unroll
                for (int j = 0; j < 16; ++j) { const v4u v = vw[q][j]; const float f = (j < cnt) ? 1.f : 0.f;
                    const float x[8] = {bflo(v.x), bfhi(v.x), bflo(v.y), bfhi(v.y), bflo(v.z), bfhi(v.z), bflo(v.w), bfhi(v.w)};
#pragma unroll
                    for (int k = 0; k < 8; ++k) { s[k] += x[k] * f; if (j == 0) c0[k] = x[k]; } }
                const float inv = 1.0f / (float)cnt; float r[8];
#pragma unroll
                for (int k = 0; k < 8; ++k) r[k] = s[k] * inv - c0[k];
                *(v4u*)(Fb + (size_t)m * KCAT + F_POOL + ch * 8) = (v4u){pk2(r[0], r[1]), pk2(r[2], r[3]), pk2(r[4], r[5]), pk2(r[6], r[7])}; } } }
    }
    {
        LAS float* cwL = (LAS float*)F.lds;
        const float* cw = a.in[12] + (size_t)l * 31 * 256;
        for (int i = tid; i < 31 * 256; i += 512) cwL[i] = cw[i];
        const f32x4 cbv = *(const f32x4*)(a.in[13] + l * 256 + 4 * lane), lgv = *(const f32x4*)(a.in[14] + l * 256 + 4 * lane), lbv = *(const f32x4*)(a.in[15] + l * 256 + 4 * lane);
        __syncthreads();
        for (int grp = F.gw; grp < M / 8; grp += F.NGW) { const int t0 = grp * 8, pos0 = t0 % SEQ;
            v2u rw[38];
#pragma unroll
            for (int r = 0; r < 38; ++r) { rw[r] = (v2u){0u, 0u}; if (pos0 - 30 + r >= 0) rw[r] = *(const v2u*)(U + (size_t)(t0 - 30 + r) * 256 + 4 * lane); }
            f32x4 y[8];
#pragma unroll
            for (int tt = 0; tt < 8; ++tt) y[tt] = cbv;
#pragma unroll
            for (int r = 0; r < 38; ++r) { const f32x4 u = (f32x4){bflo(rw[r].x), bfhi(rw[r].x), bflo(rw[r].y), bfhi(rw[r].y)};
#pragma unroll
                for (int tt = 0; tt < 8; ++tt) { const int k = r - tt; if (k >= 0 && k <= 30) { const f32x4 wk = *(const LAS f32x4*)(cwL + k * 256 + 4 * lane); y[tt] += wk * u; } } }
#pragma unroll
            for (int tt = 0; tt < 8; ++tt) { const f32x4 v = y[tt];
                const float mean = wave_sum((v.x + v.y) + (v.z + v.w)) * (1.f / 256.f); const f32x4 dlt = v - mean;
                const float var = wave_sum((dlt.x * dlt.x + dlt.y * dlt.y) + (dlt.z * dlt.z + dlt.w * dlt.w)) * (1.f / 256.f); const float rstd = 1.0f / sqrtf(var + EPS);
                f32x4 o = dlt * rstd * lgv + lbv; o.x = o.x * sigmoidf_(o.x); o.y = o.y * sigmoidf_(o.y); o.z = o.z * sigmoidf_(o.z); o.w = o.w * sigmoidf_(o.w);
                *(v2u*)(Fb + (size_t)(t0 + tt) * KCAT + F_CONV + 4 * lane) = (v2u){pk2(o.x, o.y), pk2(o.z, o.w)}; } }
        __syncthreads();
    }
    {
        typedef short bf16x8_t __attribute__((ext_vector_type(8)));
        constexpr int WLD = 136;
        LAS bf16* Wb = (LAS bf16*)F.lds;
        LAS bf16* VT = (LAS bf16*)(F.lds + 128 * WLD * 2);
        LAS f32x2* ST = (LAS f32x2*)(F.lds + 128 * WLD * 2 + 64 * WLD * 2);
        const float* sw = a.in[19] + (size_t)l * 4 * 128 * 128; const float* sb = a.in[20] + l * 4 * 128; const float* lg = a.in[17] + l * 256; const float* lb = a.in[18] + l * 256;
        const f32x2* STV = (const f32x2*)(ws + WS_STV);
        int gprev = -1;
        for (int it = blockIdx.x; it < (M / 128) * 4; it += F.G) {
            const int nb = it >> 2, g = it & 3, m0 = nb * 128;
            const bool newg = (g != gprev); gprev = g;
            f32x4 wv[8];
            if (newg) {
#pragma unroll
            for (int i = 0; i < 8; ++i) wv[i] = *(const f32x4*)(sw + (size_t)g * 16384 + (size_t)(tid + 512 * i) * 4); }
            if (tid < 128) { const f32x4 p0 = *(const f32x4*)(STV + (size_t)(m0 + tid) * 4), p1 = *(const f32x4*)(STV + (size_t)(m0 + tid) * 4 + 2);
                const float mean = ((p0[0] + p0[2]) + (p1[0] + p1[2])) * (1.f / 256.f), ex2 = ((p0[1] + p0[3]) + (p1[1] + p1[3])) * (1.f / 256.f);
                float var = ex2 - mean * mean; var = var > 0.f ? var : 0.f; ST[tid] = (f32x2){mean, 1.0f / sqrtf(var + EPS)}; }
            if (newg) {
#pragma unroll
            for (int i = 0; i < 8; ++i) { const int e = (tid + 512 * i) * 4, t = e >> 7, s0 = e & 127;
                const float w0 = (s0 + 0 <= t) ? wv[i][0] : 0.f, w1 = (s0 + 1 <= t) ? wv[i][1] : 0.f, w2 = (s0 + 2 <= t) ? wv[i][2] : 0.f, w3 = (s0 + 3 <= t) ? wv[i][3] : 0.f;
                *(LAS v2u*)(Wb + t * WLD + s0) = (v2u){pk2(w0, w1), pk2(w2, w3)}; } }
            __syncthreads();
            { const int t = tid >> 2, c16 = (tid & 3) * 16; const f32x2 st = ST[t];
              const v4u z0 = *(const v4u*)(GS + (size_t)(m0 + t) * 512 + 256 + g * 64 + c16), z1 = *(const v4u*)(GS + (size_t)(m0 + t) * 512 + 256 + g * 64 + c16 + 8);
              const float x[16] = {bflo(z0.x), bfhi(z0.x), bflo(z0.y), bfhi(z0.y), bflo(z0.z), bfhi(z0.z), bflo(z0.w), bfhi(z0.w), bflo(z1.x), bfhi(z1.x), bflo(z1.y), bfhi(z1.y), bflo(z1.z), bfhi(z1.z), bflo(z1.w), bfhi(z1.w)};
#pragma unroll
              for (int k4 = 0; k4 < 4; ++k4) { const f32x4 gv = *(const f32x4*)(lg + g * 64 + c16 + 4 * k4), bv = *(const f32x4*)(lb + g * 64 + c16 + 4 * k4);
#pragma unroll
                  for (int k = 0; k < 4; ++k) { const float o = (x[4 * k4 + k] - st.x) * st.y * gv[k] + bv[k]; VT[(c16 + 4 * k4 + k) * WLD + t] = (bf16)(pk2(o, 0.f) & 0xffffu); } } }
            __syncthreads();
            { const int t0 = wave * 16, fr = lane & 15, fq = lane >> 4; const int nks = (t0 + 15) / 32 + 1;
              f32x4 acc[4];
#pragma unroll
              for (int ct = 0; ct < 4; ++ct) acc[ct] = (f32x4){0.f, 0.f, 0.f, 0.f};
              for (int ks = 0; ks < nks; ++ks) { const bf16x8_t af = *(const LAS bf16x8_t*)(Wb + (t0 + fr) * WLD + 32 * ks + 8 * fq);
#pragma unroll
                  for (int ct = 0; ct < 4; ++ct) { const bf16x8_t bf = *(const LAS bf16x8_t*)(VT + (16 * ct + fr) * WLD + 32 * ks + 8 * fq);
                      acc[ct] = __builtin_amdgcn_mfma_f32_16x16x32_bf16(af, bf, acc[ct], 0, 0, 0); } }
              unsigned short uu[4][4]; float bias[4];
#pragma unroll
              for (int r = 0; r < 4; ++r) { const int t = t0 + 4 * fq + r; bias[r] = sb[g * 128 + t];
                  const unsigned short* up = (const unsigned short*)(GS + (size_t)(m0 + t) * 512 + g * 64 + fr);
#pragma unroll
                  for (int ct = 0; ct < 4; ++ct) uu[r][ct] = up[16 * ct]; }
#pragma unroll
              for (int r = 0; r < 4; ++r) { const int t = t0 + 4 * fq + r; bf16* op = Fb + (size_t)(m0 + t) * KCAT + F_SGU + g * 64 + fr;
#pragma unroll
                  for (int ct = 0; ct < 4; ++ct) { const float u = __uint_as_float((unsigned)uu[r][ct] << 16); op[16 * ct] = (bf16)(pk2(u * (acc[ct][r] + bias[r]), 0.f) & 0xffffu); } } }
            __syncthreads();
        }
    }
}

__device__ __forceinline__ void moe_offsets(Frame& F, int (&toff)[9]) {
    int acc = 0, c[8];
#pragma unroll
    for (int e = 0; e < 8; ++e) c[e] = (int)__hip_atomic_load((unsigned*)(F.ctl + CW_MOE + 64 * e), RLX_AGENT);
#pragma unroll
    for (int e = 0; e < 8; ++e) { toff[e] = acc; acc += (c[e] + 255) >> 8; }
    toff[8] = acc;
}
__device__ __forceinline__ void p_gather(Frame& F, const bf16* XN) {
    const int lane_v = lane_id(), tid_v = F.wave * 64 + lane_v; (void)tid_v;
    int toff[9]; moe_offsets(F, toff);
    int* tok_e = (int*)(F.ws + WS_TOK); int* tok_p = tok_e + 2 * M;
    bf16* XP = (bf16*)(F.ws + WS_XP);
    for (int m = F.gw; m < M; m += F.NGW) {
        const int e0 = tok_e[2 * m], e1 = tok_e[2 * m + 1]; int r0 = 0, r1 = 0;
#pragma unroll
        for (int e = 0; e < 8; ++e) { if (e == e0) r0 = toff[e] * 256; if (e == e1) r1 = toff[e] * 256; }
        r0 += tok_p[2 * m]; r1 += tok_p[2 * m + 1];
        const v4u a0 = __builtin_nontemporal_load((const v4u*)((const unsigned char*)XN + (size_t)m * XLD * 2 + 16 * lane_v));
        *(v4u*)((unsigned char*)XP + (size_t)r0 * DM * 2 + 16 * lane_v) = a0;
        *(v4u*)((unsigned char*)XP + (size_t)r1 * DM * 2 + 16 * lane_v) = a0;
        if (lane_v == 0) { const float sc = ((const float*)(F.ws + WS_SXN))[m]; ((float*)(F.ws + WS_SXP))[r0] = sc; ((float*)(F.ws + WS_SXP))[r1] = sc; }
        if (lane_v == 0) { tok_p[2 * m] = r0; tok_p[2 * m + 1] = r1; }
    }
    for (int idx = F.gw; idx < 8 * 256; idx += F.NGW) { const int e = idx >> 8, j = idx & 255;
        const int c = (int)__hip_atomic_load((unsigned*)(F.ctl + CW_MOE + 64 * e), RLX_AGENT); const int end = ((c + 255) >> 8) << 8;
        if (c + j < end) { int base = 0;
#pragma unroll
            for (int k = 0; k < 8; ++k) if (k == e) base = toff[k] * 256;
            const size_t r = (size_t)(base + c + j);
            *(v4u*)((unsigned char*)XP + r * DM * 2 + 16 * lane_v) = (v4u){0u, 0u, 0u, 0u}; if (lane_v == 0) ((float*)(F.ws + WS_SXP))[r] = 1.0f; } }
}
__device__ __forceinline__ void p_final(Frame& F, float* out, const float* g) {
    const int lane_v = lane_id(), tid_v = F.wave * 64 + lane_v; (void)tid_v;
    const int* tok_e = (const int*)(F.ws + WS_TOK); const int* tok_p = tok_e + 2 * M; const float* tok_w = (const float*)(tok_p + 2 * M);
    int toff[9]; moe_offsets(F, toff);
    const bf16* Y = (const bf16*)(F.ws + WS_XP);
    int lane_ = lane_v; asm volatile("" : "+v"(lane_));
    const GAS f32x4* gp = (const GAS f32x4*)g + lane_; f32x4 gv[4];
#pragma unroll
    for (int j = 0; j < 4; ++j) gv[j] = gp[64 * j];
    for (int m0 = F.gw; m0 < M; m0 += 2 * F.NGW) {
        int pr[2][2]; float wr_[2][2]; f32x4 xv[2][4]; unsigned ya_[2][4], yb_[2][4];
#pragma unroll
        for (int r = 0; r < 2; ++r) { const int mr = m0 + r * F.NGW, m = mr < M ? mr : m0;
            int p0 = tok_p[2 * m], p1 = tok_p[2 * m + 1]; { const int e0 = tok_e[2 * m], e1 = tok_e[2 * m + 1];
#pragma unroll
                for (int e = 0; e < 8; ++e) { if (e == e0) p0 += toff[e] * 256; if (e == e1) p1 += toff[e] * 256; } }
            pr[r][0] = p0; pr[r][1] = p1; wr_[r][0] = tok_w[2 * m]; wr_[r][1] = tok_w[2 * m + 1];
            const GAS v2u* xr = (const GAS v2u*)((const bf16*)(F.ws + WS_XRB) + (size_t)m * DM) + lane_;
            const GAS unsigned* y0 = (const GAS unsigned*)((const unsigned char*)Y + (size_t)(p0 < 32768 ? p0 : 0) * DM) + lane_; const GAS unsigned* y1 = (const GAS unsigned*)((const unsigned char*)Y + (size_t)(p1 < 32768 ? p1 : 0) * DM) + lane_;
#pragma unroll
            for (int j = 0; j < 4; ++j) { const v2u z = xr[64 * j]; xv[r][j] = (f32x4){bflo(z.x), bfhi(z.x), bflo(z.y), bfhi(z.y)}; ya_[r][j] = y0[64 * j]; yb_[r][j] = y1[64 * j]; } }
#pragma unroll
        for (int r = 0; r < 2; ++r) { const int m = m0 + r * F.NGW; if (m < M) {
            const int p0 = pr[r][0], p1 = pr[r][1]; const float w0 = wr_[r][0] * (p0 >= 32768 ? 1.0f : 1.0f / F8_SY), w1 = wr_[r][1] * (p1 >= 32768 ? 1.0f : 1.0f / F8_SY);
            f32x4 ya[4], yb[4];
#pragma unroll
            for (int j = 0; j < 4; ++j) { const unsigned a = ya_[r][j], b = yb_[r][j]; const auto a0 = __builtin_amdgcn_cvt_pk_f32_fp8(a, false), a1 = __builtin_amdgcn_cvt_pk_f32_fp8(a, true), b0 = __builtin_amdgcn_cvt_pk_f32_fp8(b, false), b1 = __builtin_amdgcn_cvt_pk_f32_fp8(b, true);
                ya[j] = (f32x4){a0[0], a0[1], a1[0], a1[1]}; yb[j] = (f32x4){b0[0], b0[1], b1[0], b1[1]}; }
            if (p0 >= 32768) {
#pragma unroll
                for (int j = 0; j < 4; ++j) { ya[j] = (f32x4){0.f, 0.f, 0.f, 0.f};
#pragma unroll
                    for (int ks = 0; ks < 7; ++ks) ya[j] += ((const GAS f32x4*)((const float*)(F.ws + WS_YF) + (size_t)ks * (8 * 256 * DM) + (size_t)(p0 - 32768) * DM) + lane_)[64 * j];
                    { const unsigned q = f8x4(ya[j][0] * F8_SY, ya[j][1] * F8_SY, ya[j][2] * F8_SY, ya[j][3] * F8_SY); const auto a0 = __builtin_amdgcn_cvt_pk_f32_fp8(q, false), a1 = __builtin_amdgcn_cvt_pk_f32_fp8(q, true); ya[j] = (f32x4){a0[0], a0[1], a1[0], a1[1]} * (1.0f / F8_SY); } } }
            if (p1 >= 32768) {
#pragma unroll
                for (int j = 0; j < 4; ++j) { yb[j] = (f32x4){0.f, 0.f, 0.f, 0.f};
#pragma unroll
                    for (int ks = 0; ks < 7; ++ks) yb[j] += ((const GAS f32x4*)((const float*)(F.ws + WS_YF) + (size_t)ks * (8 * 256 * DM) + (size_t)(p1 - 32768) * DM) + lane_)[64 * j];
                    { const unsigned q = f8x4(yb[j][0] * F8_SY, yb[j][1] * F8_SY, yb[j][2] * F8_SY, yb[j][3] * F8_SY); const auto b0 = __builtin_amdgcn_cvt_pk_f32_fp8(q, false), b1 = __builtin_amdgcn_cvt_pk_f32_fp8(q, true); yb[j] = (f32x4){b0[0], b0[1], b1[0], b1[1]} * (1.0f / F8_SY); } } }
            f32x4 v[4]; float s = 0.f;
#pragma unroll
            for (int j = 0; j < 4; ++j) { v[j] = xv[r][j] + ya[j] * w0 + yb[j] * w1; s += (v[j].x * v[j].x + v[j].y * v[j].y) + (v[j].z * v[j].z + v[j].w * v[j].w); }
            const float rs = 1.0f / sqrtf(wave_sum(s) * (1.f / DM) + EPS);
            GAS f32x4* xo = (GAS f32x4*)(out + (size_t)m * DM) + lane_;
#pragma unroll
            for (int j = 0; j < 4; ++j) xo[64 * j] = v[j] * rs * gv[j];
        } }
    }
}

constexpr int PL = 14, NPH = 1 + 2 * PL;
#ifndef PHMASK
#define PHMASK 0xFFFFFFFFu
#endif
#define EN(k) (((PHMASK) >> (k)) & 1u)
#ifndef REPMASK
#define REPMASK 0u
#endif
#ifndef REPCNT
#define REPCNT 1
#endif
#if REPMASK != 0
#define REP(k) for (int rep_ = 0; rep_ < 1 + REPCNT * (int)(((REPMASK) >> (k)) & 1u); ++rep_)
#else
#define REP(k)
#endif
#define IN(k) (lo <= (k) && (k) < hi)
#ifndef PROBE_BAR
#define PROBE_BAR 0
#endif
#define SEAM(k) do { if (lo <= (k) && (k) + 1 < hi) { xcd_barrier(bar); for (int pb_ = 0; pb_ < PROBE_BAR; ++pb_) xcd_barrier(bar); } } while (0)
template <int l> __device__ __forceinline__ void run_layer(Frame& F, const Args& args, const XcdBarrier& bar, const int lo, const int hi) {
    unsigned char* ws = F.ws; LAS unsigned char* ring = F.lds; float* XR = args.out; unsigned char* lds = (unsigned char*)F.lds; bf16* XRB = (bf16*)(ws + WS_XRB); (void)XR;
        const int pb = 1 + l * PL;
        bf16* XN = (bf16*)(ws + WS_XN);
        if (l == 1) { REP(1) if (EN(1) && IN(pb + 0)) { p_norm<false, true, true>(F, (const float*)XRB, args.in[1] + l * DM, XN, nullptr, nullptr, (float*)(ws + WS_SXQ)); SEAM(pb + 0); } }
        if (l == 0) { if (EN(1) && IN(pb + 0)) {
                quant_rows((bf16*)(ws + WS_WGU0), 2 * DFF, DM, (float*)(ws + WS_SWGU0), F.gw, F.NGW);
                { quant_rows((bf16*)(ws + WS_WIN), NZ, XLD, (float*)(ws + WS_SWIN), F.gw, F.NGW); quant_rows((bf16*)(ws + WS_WIN + SZ_WIN), NZ, XLD, (float*)(ws + WS_SWIN) + NZ, F.gw, F.NGW); }
            SEAM(pb + 0); } }
        REP(2) if (EN(2) && IN(pb + 1)) {
            WinOrder S; S.c = (int)blockIdx.x; S.G = F.G; S.A = (const char*)XN; S.B = (const char*)(ws + WS_WIN + l * SZ_WIN); S.a_tile = (size_t)256 * XLD * 2; S.b_tile = (size_t)256 * XLD * 2; S.nt = DM / 128;
            EpiZ2T<true> E{ws, (const float*)(ws + WS_SXQ), (const float*)(ws + WS_SWIN) + l * NZ};
            pg8::gemm_phase<EpiZ2T<true>, WinOrder, true, 1>(ring, pg8::Gemm{XLD, XLD}, S, E, F.wave);
            SEAM(pb + 1);
        }
        if (EN(3) && IN(pb + 2)) {
            p_thin(F, args, l);
#if (REPMASK & 8)
            for (int rp_ = 0; rp_ < REPCNT; ++rp_) { __syncthreads(); p_thin(F, args, l); }
#endif
            { TileOrder S; S.so.init(M, 768, F.G, (int)blockIdx.x); S.A = (const char*)(ws + WS_ZQ); S.B = (const char*)(ws + WS_WUQ + l * SZ_WUQ); S.a_tile = (size_t)256 * 256 * 2; S.b_tile = (size_t)256 * 256 * 2; S.nt = 4;
              EpiQ E{(bf16*)(ws + WS_QRAW), (const float*)(ws + WS_SSQ), (const float*)(ws + WS_CS)};
              pg8::gemm_phase<EpiQ, TileOrder, true>(ring, pg8::Gemm{256, 256}, S, E, F.wave); }
            { TileOrder S; S.so.init(M, 1024, F.G, (int)blockIdx.x); S.A = (const char*)(ws + WS_ZKV); S.B = (const char*)(ws + WS_WUKV + l * SZ_WUKV); S.a_tile = (size_t)256 * 256 * 2; S.b_tile = (size_t)256 * 256 * 2; S.nt = 4;
              EpiKV E{(bf16*)(ws + WS_KF), (bf16*)(ws + WS_VB), (const float*)(ws + WS_SSK)};
              pg8::gemm_phase<EpiKV, TileOrder, true>(ring, pg8::Gemm{256, 256}, S, E, F.wave); }
#if (REPMASK & 0x40000)
            for (int rp_ = 0; rp_ < REPCNT; ++rp_) {
            { TileOrder S; S.so.init(M, 768, F.G, (int)blockIdx.x); S.A = (const char*)(ws + WS_ZQ); S.B = (const char*)(ws + WS_WUQ + l * SZ_WUQ); S.a_tile = (size_t)256 * 256 * 2; S.b_tile = (size_t)256 * 256 * 2; S.nt = 4;
              EpiQ E{(bf16*)(ws + WS_QRAW), (const float*)(ws + WS_SSQ), (const float*)(ws + WS_CS)};
              pg8::gemm_phase<EpiQ, TileOrder, true>(ring, pg8::Gemm{256, 256}, S, E, F.wave); }
            { TileOrder S; S.so.init(M, 1024, F.G, (int)blockIdx.x); S.A = (const char*)(ws + WS_ZKV); S.B = (const char*)(ws + WS_WUKV + l * SZ_WUKV); S.a_tile = (size_t)256 * 256 * 2; S.b_tile = (size_t)256 * 256 * 2; S.nt = 4;
              EpiKV E{(bf16*)(ws + WS_KF), (bf16*)(ws + WS_VB), (const float*)(ws + WS_SSK)};
              pg8::gemm_phase<EpiKV, TileOrder, true>(ring, pg8::Gemm{256, 256}, S, E, F.wave); }
            }
#endif
            SEAM(pb + 3);
        }
        REP(5) if (EN(5) && IN(pb + 4)) {
            for (int pid = blockIdx.x; pid < 256; pid += F.G) { const int bh = 2 * (pid & 7) + (pid >> 7), s = (pid >> 3) & 15;
                att2::attn_unit<8>(bh >> 3, bh & 7, 31 - s, (const att2::bf16*)(ws + WS_QRAW), (const att2::bf16*)(ws + WS_KF), (const att2::bf16*)(ws + WS_VB), (att2::bf16*)(ws + WS_F), (char*)lds, F.wave);
                att2::attn_unit<8>(bh >> 3, bh & 7, s, (const att2::bf16*)(ws + WS_QRAW), (const att2::bf16*)(ws + WS_KF), (const att2::bf16*)(ws + WS_VB), (att2::bf16*)(ws + WS_F), (char*)lds, F.wave); }
            SEAM(pb + 4);
        }
        REP(6) if (EN(6) && IN(pb + 5)) {
            BranchOrder S; S.so.init(M, DM, F.G, (int)blockIdx.x); S.XNp = (const char*)XN; S.Wz = (const char*)(ws + WS_WIN + l * SZ_WIN) + (size_t)1792 * XLD * 2; S.Fp = (const char*)(ws + WS_F); S.Wc = (const char*)(ws + WS_WCAT + l * SZ_WCAT);
            EpiGate E{(bf16*)(ws + WS_TG) + (size_t)blockIdx.x * 65536, args.in[3] + l * 4096, (bf16*)(ws + WS_MG), (const float*)(ws + WS_SXQ), (const float*)(ws + WS_SWIN) + l * NZ + 1792};
            pg8::gemm_phase<EpiGate, BranchOrder, true, 2>(ring, pg8::Gemm{XLD, KCAT}, S, E, F.wave);
#if (REPMASK & 0x10000)
            for (int rp_ = 0; rp_ < REPCNT; ++rp_) pg8::gemm_phase<EpiGate, BranchOrder, true>(ring, pg8::Gemm{XLD, KCAT}, S, E, F.wave);
#endif
            SEAM(pb + 5);
        }
        REP(7) if (EN(7) && IN(pb + 6)) {
            TileOrder S; S.so.init(M, DM, F.G, (int)blockIdx.x); S.A = (const char*)(ws + WS_MG); S.B = (const char*)(ws + WS_WO + l * SZ_WO); S.a_tile = (size_t)256 * DM * 2; S.b_tile = (size_t)256 * DM * 2; S.nt = DM / 64;
            if constexpr (l == 0) { EpiResB<float> E{args.in[0], XRB}; pg8::gemm_phase<EpiResB<float>, TileOrder, true>(ring, pg8::Gemm{DM, DM}, S, E, F.wave); }
            else { EpiResB<bf16> E{XRB, XRB}; pg8::gemm_phase<EpiResB<bf16>, TileOrder, true>(ring, pg8::Gemm{DM, DM}, S, E, F.wave); }
            SEAM(pb + 6);
        }
        if (l == 0) {
            REP(8) if (EN(8) && IN(pb + 7)) { p_norm<false, true, true>(F, (const float*)XRB, args.in[23] + l * DM, XN, nullptr, nullptr, (float*)(ws + WS_SXN)); SEAM(pb + 7); }
            REP(9) if (EN(9) && IN(pb + 8)) {
                TileOrder S; S.so.init(M, 2 * DFF, F.G, (int)blockIdx.x); S.A = (const char*)XN; S.B = (const char*)(ws + WS_WGU0); S.a_tile = (size_t)256 * XLD * 2; S.b_tile = (size_t)256 * DM * 2; S.nt = DM / 128;
                EpiSwiGLUT<true> E{(bf16*)(ws + WS_H), DFF, 0, (const float*)(ws + WS_SXN), (const float*)(ws + WS_SWGU0)};
                pg8::gemm_phase<EpiSwiGLUT<true>, TileOrder, true, 1>(ring, pg8::Gemm{XLD, DM}, S, E, F.wave);
                SEAM(pb + 8);
            }
            REP(10) if (EN(10) && IN(pb + 9)) {
                TileOrder S; S.so.init(M, DM, F.G, (int)blockIdx.x); S.A = (const char*)(ws + WS_H); S.B = (const char*)(ws + WS_WD0); S.a_tile = (size_t)256 * DFF * 2; S.b_tile = (size_t)256 * DFF * 2; S.nt = DFF / 64;
                EpiResB<bf16> E{XRB, XRB};
                pg8::gemm_phase<EpiResB<bf16>, TileOrder, true>(ring, pg8::Gemm{DFF, DFF}, S, E, F.wave);
                SEAM(pb + 9 + 4);
            }
        } else {
            REP(11) if (EN(11) && IN(pb + 7)) { p_norm<true, true, true>(F, (const float*)XRB, args.in[23] + l * DM, (bf16*)(ws + WS_XN2), args.in[27], args.in[28], (float*)(ws + WS_SXN)); SEAM(pb + 7); }
            for (int ch = 0; ch < 1; ++ch) {
                int toff[9];
                REP(13) if (EN(13) && IN(pb + 9 + 2 * ch)) {
                    moe_offsets(F, toff); const int rt0 = ch * MOE_CH, rt1 = toff[8] < (ch + 1) * MOE_CH ? toff[8] : (ch + 1) * MOE_CH;
                    if (rt1 > rt0) {
                        MoeOrder S; S.so.nM = rt1; S.so.nN = 2 * DFFE / 256; S.so.nwg = rt1 * (2 * DFFE / 256); S.so.G = F.G; S.so.c = (int)blockIdx.x; S.nt = DM / 128;
                        S.A = (const char*)(ws + WS_XN2); S.B = (const char*)(ws + WS_MGU); S.a_tile = 0; S.b_tile = (size_t)256 * DM; S.b_exp = SZ_MGU8; S.tix = (const int*)(ws + WS_TIX);
#pragma unroll
                        for (int k = 0; k < 9; ++k) S.toff[k] = toff[k];
#pragma unroll
                        for (int k = 0; k < 8; ++k) S.cnt[k] = (int)__hip_atomic_load((unsigned*)(F.ctl + CW_MOE + 64 * k), RLX_AGENT);
#if MOE_UP_F8
                        EpiSwiGLUT<false, true, true> E{(bf16*)(ws + WS_HC), DFFE, rt0, (const float*)(ws + WS_SXN), (const float*)(ws + WS_SWMOE)};
                        pg8::gemm_phase<EpiSwiGLUT<false, true, true>, MoeOrder, true, 3, true>(ring, pg8::Gemm{XLD, DM / 2}, S, E, F.wave);
#else
                        EpiSwiGLUT<true, true> E{(bf16*)(ws + WS_HC), DFFE, rt0, (const float*)(ws + WS_SXN), (const float*)(ws + WS_SWMOE)};
                        pg8::gemm_phase<EpiSwiGLUT<true, true>, MoeOrder, true, 1, true>(ring, pg8::Gemm{XLD, DM / 2}, S, E, F.wave);
#endif
                    }
                    SEAM(pb + 9 + 2 * ch);
                }
                REP(14) if (EN(14) && IN(pb + 10 + 2 * ch)) {
                    moe_offsets(F, toff); const int rt0 = ch * MOE_CH, rt1 = toff[8] < (ch + 1) * MOE_CH ? toff[8] : (ch + 1) * MOE_CH;
                    if (rt1 > rt0) {
                        const int nreg = rt1 < 128 ? rt1 : 128;
                        MoeDownOrder S; S.so.nM = nreg; S.so.nN = DM / 256; S.so.nwg = nreg * (DM / 256); S.so.G = F.G; S.so.c = 0; S.G = F.G; S.c = (int)blockIdx.x; S.nsub = (rt1 - nreg) * 28;
                        S.A = (const char*)(ws + WS_HC); S.B = (const char*)(ws + WS_MD); S.a_tile = (size_t)256 * DFFE; S.b_tile = (size_t)256 * DFFE; S.b_exp = SZ_MD / 2;
#pragma unroll
                        for (int k = 0; k < 9; ++k) S.toff[k] = toff[k];
                        EpiMoeDown E{(bf16*)(ws + WS_XP), (float*)(ws + WS_YF)};
                        pg8::gemm_phase<EpiMoeDown, MoeDownOrder, true, 3>(ring, pg8::Gemm{DFFE / 2, DFFE / 2}, S, E, F.wave);
                    }
                    SEAM(pb + 12);
                }
            }
            REP(15) if (EN(15) && IN(pb + 13)) { p_final(F, XR, args.in[32]); }
        }
    }
__global__ void __launch_bounds__(NWAVES * 64, 2) fwd_kernel(Args args_in_kernarg) {
    const Args& args = *(const Args*)__builtin_amdgcn_kernarg_segment_ptr();
    extern __shared__ __attribute__((aligned(16))) unsigned char lds[];
    Frame F;
    F.lds = (LAS unsigned char*)lds; F.MISC = (volatile LAS unsigned*)(F.lds + MISC_OFF);
    F.wave = __builtin_amdgcn_readfirstlane((int)threadIdx.x >> 6);
    F.G = gridDim.x; F.gw = blockIdx.x * NWAVES + F.wave; F.NGW = F.G * NWAVES;
    F.ws = args.ws; F.ctl = (gu32*)(args.ws + WS_CTL);
    unsigned char* ws = args.ws;
    for (int u = threadIdx.x; u < (LDS_BYTES - LDSCTL_OFF) / 4; u += NWAVES * 64) ((LAS unsigned*)(F.lds + LDSCTL_OFF))[u] = 0u;
    __syncthreads();
    XcdBarrier bar; bar.bar = (unsigned*)(F.ctl + CW_BAR); bar.x = 0; bar.st = nullptr;
    const int lo = args.ph_lo, hi = args.ph_hi;
    if (hi - lo > 1) bar = xcd_barrier_post((unsigned*)(F.ctl + CW_BAR), F.MISC + 8);
    bar.wave = F.wave;
    LAS unsigned char* ring = F.lds;
    float* XR = args.out;

    if (EN(0) && IN(0)) { p_prologue(F, args); p_norm<false, true>(F, args.in[0], args.in[1], (bf16*)(ws + WS_XN), nullptr, nullptr, (float*)(ws + WS_SXQ));
#if (REPMASK & 1)
        for (int rp_ = 0; rp_ < REPCNT; ++rp_) { __syncthreads(); p_prologue(F, args); }
#endif
        SEAM(0); }

    run_layer<0>(F, args, bar, lo, hi);
    run_layer<1>(F, args, bar, lo, hi);
}

extern "C" void kernel_launch(void* const* d_in, const int* in_sizes, int n_in, void* d_out, int out_size, void* d_ws, size_t ws_size, hipStream_t stream) {
    static int grid = 0;
    if (grid == 0) {
        if (n_in != 33 || in_sizes[0] != M * DM || out_size != M * DM || ws_size < WS_END) {
            fprintf(stderr, "kernel_launch: unexpected shapes: n_in %d in0 %d out %d ws %zu (need >= %zu)\n", n_in, n_in > 0 ? in_sizes[0] : -1, out_size, ws_size, (size_t)WS_END); grid = -1; return; }
        int dev = 0, cus = 0, per_cu = 0;
        if (hipGetDevice(&dev) != hipSuccess || hipDeviceGetAttribute(&cus, hipDeviceAttributeMultiprocessorCount, dev) != hipSuccess) { grid = -1; return; }
        if (hipFuncSetAttribute((const void*)fwd_kernel, hipFuncAttributeMaxDynamicSharedMemorySize, LDS_BYTES) != hipSuccess) { fprintf(stderr, "kernel_launch: hipFuncSetAttribute failed\n"); grid = -1; return; }
        if (hipOccupancyMaxActiveBlocksPerMultiprocessor(&per_cu, (const void*)fwd_kernel, NWAVES * 64, LDS_BYTES) != hipSuccess || per_cu < 1)
            fprintf(stderr, "kernel_launch: occupancy query reports %d blocks per CU\n", per_cu);
        (void)hipGetLastError();
        grid = cus;
    }
    if (grid < 0) return;
    if (hipMemsetAsync((char*)d_ws + WS_CTL, 0, CTL_ZERO_BYTES, stream) != hipSuccess) return;
    Args a{};
    for (int i = 0; i < 33; ++i) a.in[i] = (const float*)d_in[i];
    a.out = (float*)d_out; a.ws = (unsigned char*)d_ws; a.li = 0; a.pad = 0;
#if NLAUNCH_MODE == 1
    a.ph_lo = 0; a.ph_hi = NPH;
    hipLaunchKernelGGL(fwd_kernel, dim3(grid), dim3(NWAVES * 64), LDS_BYTES, stream, a);
#else
    for (int ph = 0; ph < NPH; ++ph) {
        if ((ph >= 1 + 10 && ph <= 1 + 13) || ph == 1 + PL + 8 || ph == 1 + PL + 11 || ph == 1 + PL + 12 || ph == 1 + 3 || ph == 1 + PL + 3) continue;
        a.ph_lo = ph; a.ph_hi = ph + 1; a.li = 0;
        hipLaunchKernelGGL(fwd_kernel, dim3(grid), dim3(NWAVES * 64), LDS_BYTES, stream, a);
    }
#endif
    const hipError_t le = hipPeekAtLastError();
    if (le != hipSuccess) fprintf(stderr, "kernel_launch: launch failed: %s\n", hipGetErrorName(le));
}
```

```cpp
#include <hip/hip_runtime.h>
#include <hip/hip_bf16.h>
#include <cstdio>
#include <cstdint>
#include <cmath>

#ifndef GATE_I8
#define GATE_I8 1
#endif
#ifndef MOE_UP_F8
#define MOE_UP_F8 1
#endif
#ifndef NLAUNCH_MODE
#define NLAUNCH_MODE 1
#endif

__device__ __forceinline__ int lane_id() { return (int)__builtin_amdgcn_mbcnt_hi(~0u, __builtin_amdgcn_mbcnt_lo(~0u, 0u)); }
namespace pg8 {
#define PG8_LAS __attribute__((address_space(3)))
typedef unsigned short bf16_t;
typedef short bf16x8 __attribute__((ext_vector_type(8)));
typedef float f32x4 __attribute__((ext_vector_type(4)));
typedef unsigned u32x4 __attribute__((ext_vector_type(4)));
typedef int i32x4 __attribute__((ext_vector_type(4)));
typedef int i32x8 __attribute__((ext_vector_type(8)));
constexpr int BM = 256, BK = 64, HALF = 128, HTB = HALF * BK * 2, STAGE_BYTES = 8 * HTB, NXCD = 8, WGM = 8;
constexpr int SCB_OFF = 132096;
constexpr int IDX_OFF = 136192;

__host__ __device__ __forceinline__ int lds_byte(int r, int c) { const int st = (r >> 4) * 2 + (c >> 5), rr = r & 15, cc = c & 31, ob = rr * 64 + cc * 2; return st * 1024 + (ob ^ (((ob >> 9) & 1) << 5)); }
__host__ __device__ __forceinline__ void stage_rc(int b, int& R, int& C) { const int st = b / 1024, sb = b % 1024, swz = sb ^ (((sb >> 9) & 1) << 5); R = (st >> 1) * 16 + swz / 64; C = (st & 1) * 32 + (swz % 64) / 2; }
__host__ __device__ __forceinline__ int perm32(int rho) { const int n = rho >> 4, i = rho & 15; return 8 * (i >> 2) + 4 * n + (i & 3); }

struct Unit { int pm, pn, nt, aux; const char* A; const char* B; const int* rix; int nv; };
struct Gemm { int lda, ldb; };

struct StaticOrder {
    int nM, nN, nwg, G, c;
    __host__ __device__ void init(int M, int N, int G_, int c_) { nM = M / BM; nN = N / BM; nwg = nM * nN; G = G_; c = c_; }
    __host__ __device__ bool tile(int i, int& pm, int& pn) const { return tileL((long)i * G + c, pm, pn); }
    __host__ __device__ bool tileL(const long L, int& pm, int& pn) const {
        if (L >= nwg) return false;
        int wgid = (int)L; { const int q = nwg / NXCD, r = nwg % NXCD, xcd = wgid % NXCD, off = wgid / NXCD; wgid = (xcd < r ? xcd * (q + 1) : r * (q + 1) + (xcd - r) * q) + off; }
        const int nig = WGM * nN, gid = wgid / nig, fm = gid * WGM, gsz = (nM - fm) < WGM ? (nM - fm) : WGM;
        pm = fm + ((wgid % nig) % gsz); pn = (wgid % nig) / gsz; return true;
    }
};

__device__ __forceinline__ unsigned cvt_pk_bf16(float lo, float hi) { unsigned r; asm volatile("s_nop 1\n\tv_cvt_pk_bf16_f32 %0, %1, %2" : "=v"(r) : "v"(lo), "v"(hi)); return r; }
__device__ __forceinline__ float bf_lo(unsigned w) { return __uint_as_float(w << 16); }
__device__ __forceinline__ float bf_hi(unsigned w) { return __uint_as_float(w & 0xffff0000u); }


template <class Epi, class Sched, bool ALIGN_EPI, int I8 = 0, bool GATHER = false>
__device__ __forceinline__ void gemm_phase(PG8_LAS unsigned char* lds, const Gemm g, const Sched& S, const Epi& E, const int wid) {
    int lane = lane_id(); asm volatile("" : "+v"(lane));
    const int tid = wid * 64 + lane, wr = wid >> 2, wc = wid & 3, fr = lane & 15, fq = lane >> 4;
    unsigned voffA[2], voffB[2]; int gR[2]; unsigned gCb[2];
#pragma unroll
    for (int i = 0; i < 2; ++i) { int R, C; stage_rc(tid * 16 + i * 8192, R, C); const int Rb = Epi::PERM ? ((R & ~31) + perm32(R & 31)) : R;
        voffA[i] = (unsigned)(R * g.lda + C) * 2u; voffB[i] = (unsigned)(Rb * g.ldb + C) * 2u; gR[i] = R; gCb[i] = (unsigned)C * 2u; }
    unsigned gC[2][2], gN[2][2]; (void)gR; (void)gCb;
#pragma unroll
    for (int h = 0; h < 2; ++h)
#pragma unroll
        for (int i = 0; i < 2; ++i) { gC[h][i] = 0u; gN[h][i] = 0u; }
#define PG8_LDIDX(par, nv_, G_) do { _Pragma("unroll") for (int h_ = 0; h_ < 2; ++h_) _Pragma("unroll") for (int i_ = 0; i_ < 2; ++i_) { const int row_ = 128 * h_ + gR[i_]; \
        int tok_ = *(const PG8_LAS int*)(lds + IDX_OFF + (par) * 1024 + row_ * 4); tok_ = row_ < (nv_) ? tok_ : 0; G_[h_][i_] = (unsigned)tok_ * (unsigned)(g.lda * 2) + gCb[i_]; } } while (0)
    const size_t kstep = (size_t)(BK * 2);
    const unsigned hstepA = GATHER ? 0u : (unsigned)(HALF * g.lda * 2), hstepB = (unsigned)(HALF * g.ldb * 2);
    const unsigned ldsw = (unsigned)wid * 1024u;
    const int aoff = lds_byte(wr * 64 + fr, fq * 8), boff = lds_byte(wc * 32 + fr, fq * 8);
#define PG8_SA(b, h) (((b) * 2 + (h)) * HTB)
#define PG8_SB(b, h) ((4 + (b) * 2 + (h)) * HTB)
#define PG8_STAGE(bufoff, gbase, voff) do { _Pragma("unroll") for (int _i = 0; _i < 2; ++_i) \
        __builtin_amdgcn_global_load_lds((const unsigned*)((const char*)(gbase) + (voff)[_i]), (PG8_LAS unsigned*)(lds + (bufoff) + ldsw + _i * 8192), 16, 0, 0); } while (0)
#define PG8_LDA(dst, b, h) do { _Pragma("unroll") for (int m = 0; m < 4; ++m) _Pragma("unroll") for (int k = 0; k < 2; ++k) dst[m][k] = *(const PG8_LAS bf16x8*)(lds + PG8_SA(b, h) + aoff + m * 2048 + k * 1024); } while (0)
#define PG8_LDB(dst, b, h) do { _Pragma("unroll") for (int n = 0; n < 2; ++n) _Pragma("unroll") for (int k = 0; k < 2; ++k) dst[n][k] = *(const PG8_LAS bf16x8*)(lds + PG8_SB(b, h) + boff + n * 2048 + k * 1024); } while (0)
#define PG8_MMA_I8(ai, bj, At, Bt) do { __builtin_amdgcn_s_setprio(1); _Pragma("unroll") for (int m = 0; m < 4; ++m) _Pragma("unroll") for (int n = 0; n < 2; ++n) _Pragma("unroll") for (int k = 0; k < 2; ++k) \
            acc[ai][bj][m][n] = __builtin_bit_cast(f32x4, __builtin_amdgcn_mfma_i32_16x16x64_i8(__builtin_bit_cast(i32x4, Bt[n][k]), __builtin_bit_cast(i32x4, At[m][k]), __builtin_bit_cast(i32x4, acc[ai][bj][m][n]), 0, 0, 0)); \
        __builtin_amdgcn_s_setprio(0); } while (0)
#define PG8_MMA_F8(ai, bj, At, Bt) do { __builtin_amdgcn_s_setprio(1); _Pragma("unroll") for (int m = 0; m < 4; ++m) _Pragma("unroll") for (int n = 0; n < 2; ++n) { \
            const i32x4 bl_ = __builtin_bit_cast(i32x4, Bt[n][0]), bh_ = __builtin_bit_cast(i32x4, Bt[n][1]), al_ = __builtin_bit_cast(i32x4, At[m][0]), ah_ = __builtin_bit_cast(i32x4, At[m][1]); \
            const i32x8 b8_ = __builtin_shufflevector(bl_, bh_, 0, 1, 2, 3, 4, 5, 6, 7), a8_ = __builtin_shufflevector(al_, ah_, 0, 1, 2, 3, 4, 5, 6, 7); \
            asm volatile("v_mfma_scale_f32_16x16x128_f8f6f4 %0, %1, %2, %0, %3, %3 op_sel_hi:[0,0,0]" : "+v"(acc[ai][bj][m][n]) : "v"(b8_), "v"(a8_), "v"(f8one)); } \
        __builtin_amdgcn_s_setprio(0); } while (0)
#define PG8_MMA_BF(ai, bj, At, Bt) do { __builtin_amdgcn_s_setprio(1); _Pragma("unroll") for (int m = 0; m < 4; ++m) _Pragma("unroll") for (int n = 0; n < 2; ++n) _Pragma("unroll") for (int k = 0; k < 2; ++k) \
            acc[ai][bj][m][n] = __builtin_amdgcn_mfma_f32_16x16x32_bf16(Bt[n][k], At[m][k], acc[ai][bj][m][n], 0, 0, 0); \
        __builtin_amdgcn_s_setprio(0); } while (0)
#define PG8_WAIT_V(n) asm volatile("s_waitcnt vmcnt(" #n ")" ::: "memory")
#define PG8_WAIT_L(n) asm volatile("s_waitcnt lgkmcnt(" #n ")" ::: "memory")
#define PG8_BAR __builtin_amdgcn_s_barrier()
#define PG8_SCHED __builtin_amdgcn_sched_barrier(0)
    Unit cur, nxt; int ui = 0;
    if (!S.next(0, cur)) return;
    int f8one = 0x7F7F7F7F; if constexpr (I8 == 3) asm volatile("" : "+v"(f8one)); (void)f8one;
    unsigned gst[(I8 == 2) ? 32 : 1]; (void)gst;
    if constexpr (I8 == 2) {
#pragma unroll
        for (int i = 0; i < 32; ++i) gst[i] = 0u; }
    f32x4 acc[2][2][4][2];
#pragma unroll
    for (int a = 0; a < 2; ++a)
#pragma unroll
        for (int b = 0; b < 2; ++b)
#pragma unroll
            for (int m = 0; m < 4; ++m)
#pragma unroll
                for (int n = 0; n < 2; ++n) acc[a][b][m][n] = (f32x4){0.f, 0.f, 0.f, 0.f};
    bf16x8 At[4][2], B0[2][2], B1[2][2];
    const char* cA = cur.A; const char* cB = cur.B;
    if constexpr (GATHER) {
        if (wid == 2) __builtin_amdgcn_global_load_lds((const unsigned*)(cur.rix + lane * 4), (PG8_LAS unsigned*)(lds + IDX_OFF), 16, 0, 0);
        asm volatile("s_waitcnt vmcnt(0)" ::: "memory"); PG8_BAR; asm volatile("" ::: "memory");
        PG8_LDIDX(0, cur.nv, gC);
    }
    { unsigned p0_[2], p1_[2];
#pragma unroll
      for (int i = 0; i < 2; ++i) { p0_[i] = GATHER ? gC[0][i] : voffA[i]; p1_[i] = GATHER ? gC[1][i] : voffA[i]; }
    PG8_STAGE(PG8_SB(0, 0), cB, voffB); PG8_STAGE(PG8_SB(0, 1), cB + hstepB, voffB); PG8_STAGE(PG8_SA(0, 0), cA, p0_); PG8_STAGE(PG8_SA(0, 1), cA + hstepA, p1_);
    if (wr == 1) PG8_BAR;
    PG8_WAIT_V(2); PG8_BAR;
    PG8_STAGE(PG8_SB(1, 0), cB + kstep, voffB); PG8_STAGE(PG8_SA(1, 0), cA + kstep, p0_); PG8_STAGE(PG8_SB(1, 1), cB + hstepB + kstep, voffB); }
    PG8_WAIT_V(6); PG8_BAR;
    for (;;) {
        const bool has_next = S.next(ui + 1, nxt);
        const int nt = cur.nt; bool cur_i8 = (I8 == 1); if constexpr (I8 == 2) cur_i8 = Epi::unit_i8(cur); (void)cur_i8;
        if constexpr (GATHER) {
            if (!has_next) {
#pragma unroll
                for (int h = 0; h < 2; ++h)
#pragma unroll
                    for (int i = 0; i < 2; ++i) gN[h][i] = gC[h][i]; }
            if (wid == 2 && has_next) __builtin_amdgcn_global_load_lds((const unsigned*)(nxt.rix + lane * 4), (PG8_LAS unsigned*)(lds + IDX_OFF + ((ui + 1) & 1) * 1024), 16, 0, 0);
            if constexpr (I8 != 3) { if (wid == 1) __builtin_amdgcn_global_load_lds((const unsigned*)(E.pf_ptr(cur, 1) + lane * 4), (PG8_LAS unsigned*)(lds + SCB_OFF + (ui & 1) * 2048 + 1024), 16, 0, 0); }
            if (I8 != 3 && wid == 0) {
#pragma unroll
                for (int q = 0; q < 4; ++q) { const int row_ = 64 * q + lane; int tok_ = *(const PG8_LAS int*)(lds + IDX_OFF + (ui & 1) * 1024 + row_ * 4); tok_ = row_ < cur.nv ? tok_ : 0;
                    __builtin_amdgcn_global_load_lds((const unsigned*)(E.sx + tok_), (PG8_LAS unsigned*)(lds + SCB_OFF + (ui & 1) * 2048 + q * 256), 4, 0, 0); } }
        } else
        if constexpr (I8 == 1 || I8 == 2) { if (wid < 2) { const float* sp_ = E.pf_ptr(cur, wid);
                int l4_ = lane_id() * 4; asm volatile("" : "+v"(l4_));
                if (sp_) __builtin_amdgcn_global_load_lds((const unsigned*)(sp_ + l4_), (PG8_LAS unsigned*)(lds + SCB_OFF + (ui & 1) * 2048 + wid * 1024), 16, 0, 0); } }
        const char* nA = has_next ? nxt.A : cA; const char* nB = has_next ? nxt.B : cB;
#define PG8_KLOOP(MMAX) \
        for (int t = 0; t < nt; t += 2) { \
            const bool last = (t == nt - 2); \
            const char* a1 = cA + (size_t)(t + 1) * kstep; \
            const char* a2 = last ? nA : cA + (size_t)(t + 2) * kstep; const char* b2 = last ? nB : cB + (size_t)(t + 2) * kstep; \
            const char* a3 = a2 + kstep; const char* b3 = b2 + kstep; \
            unsigned c1_[2], s0_[2], s1_[2]; \
            if constexpr (GATHER) { if (last && has_next) PG8_LDIDX((ui + 1) & 1, nxt.nv, gN); \
                _Pragma("unroll") for (int i = 0; i < 2; ++i) { c1_[i] = gC[1][i]; s0_[i] = last ? gN[0][i] : gC[0][i]; s1_[i] = last ? gN[1][i] : gC[1][i]; } } \
            else { _Pragma("unroll") for (int i = 0; i < 2; ++i) { c1_[i] = voffA[i]; s0_[i] = voffA[i]; s1_[i] = voffA[i]; } } \
            PG8_LDB(B0, 0, 0); PG8_LDB(B1, 0, 1); PG8_SCHED; PG8_LDA(At, 0, 0); PG8_STAGE(PG8_SA(1, 1), a1 + hstepA, c1_); \
            PG8_WAIT_V(8); PG8_WAIT_L(0); PG8_BAR; MMAX(0, 0, At, B0); MMAX(0, 1, At, B1); PG8_BAR; PG8_SCHED; \
            PG8_LDA(At, 0, 1); PG8_STAGE(PG8_SB(0, 0), b2, voffB); PG8_STAGE(PG8_SB(0, 1), b2 + hstepB, voffB); PG8_STAGE(PG8_SA(0, 0), a2, s0_); \
            PG8_WAIT_V(8); PG8_WAIT_L(0); PG8_BAR; MMAX(1, 0, At, B0); MMAX(1, 1, At, B1); PG8_BAR; PG8_SCHED; \
            PG8_LDB(B0, 1, 0); PG8_LDB(B1, 1, 1); PG8_SCHED; PG8_LDA(At, 1, 0); PG8_STAGE(PG8_SA(0, 1), a2 + hstepA, s1_); \
            PG8_WAIT_V(8); PG8_WAIT_L(0); PG8_BAR; MMAX(0, 0, At, B0); MMAX(0, 1, At, B1); PG8_BAR; PG8_SCHED; \
            PG8_LDA(At, 1, 1); PG8_STAGE(PG8_SB(1, 0), b3, voffB); PG8_STAGE(PG8_SB(1, 1), b3 + hstepB, voffB); PG8_STAGE(PG8_SA(1, 0), a3, s0_); \
            PG8_WAIT_V(8); PG8_WAIT_L(0); PG8_BAR; MMAX(1, 0, At, B0); MMAX(1, 1, At, B1); PG8_BAR; PG8_SCHED; \
        }
        if constexpr (I8 == 2) { if (cur_i8) { PG8_KLOOP(PG8_MMA_I8) } else { PG8_KLOOP(PG8_MMA_BF) } }
        else if constexpr (I8 == 1) { PG8_KLOOP(PG8_MMA_I8) }
        else if constexpr (I8 == 3) { PG8_KLOOP(PG8_MMA_F8) }
        else { PG8_KLOOP(PG8_MMA_BF) }
#undef PG8_KLOOP
        if constexpr (ALIGN_EPI) { if (wr == 0) PG8_BAR; }
        if constexpr (I8 == 2) E(acc, cur, wr, wc, fr, fq, (const PG8_LAS float*)(lds + SCB_OFF + (ui & 1) * 2048), gst);
        else if constexpr (I8 == 1) E(acc, cur, wr, wc, fr, fq, (const PG8_LAS float*)(lds + SCB_OFF + (ui & 1) * 2048)); else E(acc, cur, wr, wc, fr, fq);
        if (!has_next) break;
#pragma unroll
        for (int a = 0; a < 2; ++a)
#pragma unroll
            for (int b = 0; b < 2; ++b)
#pragma unroll
                for (int m = 0; m < 4; ++m)
#pragma unroll
                    for (int n = 0; n < 2; ++n) acc[a][b][m][n] = (f32x4){0.f, 0.f, 0.f, 0.f};
        cur = nxt; cA = nA; cB = nB; ++ui;
        if constexpr (GATHER) {
#pragma unroll
            for (int h = 0; h < 2; ++h)
#pragma unroll
                for (int i = 0; i < 2; ++i) gC[h][i] = gN[h][i]; }
        if constexpr (ALIGN_EPI) { if (wr == 1) PG8_BAR; }
    }
    PG8_WAIT_V(0);
    if constexpr (!ALIGN_EPI) { if (wr == 0) PG8_BAR; }
    PG8_BAR;
#undef PG8_LDIDX
#undef PG8_SA
#undef PG8_SB
#undef PG8_STAGE
#undef PG8_LDA
#undef PG8_LDB
#undef PG8_MMA_I8
#undef PG8_MMA_BF
#undef PG8_MMA_F8
#undef PG8_WAIT_V
#undef PG8_WAIT_L
#undef PG8_BAR
#undef PG8_SCHED
}
}

constexpr int NWAVES = 8;
constexpr int BATCH = 2, SEQ = 8192, DM = 1024, M = BATCH * SEQ;
constexpr int D_IN = 5792, NZ = 5888;
constexpr int DFF = 2816, NEXP = 8, DFFE = 3584;
constexpr int KCAT = 1280;
constexpr int F_POOL = 0, F_MLA = 256, F_CONV = 768, F_SGU = 1024;
constexpr float EPS = 1e-6f;
constexpr int MOE_TILES_MAX = 136, MOE_CH = 136;

#ifndef ATT_NEGM
#define ATT_NEGM 1
#endif
namespace att2 {
using bf16=__hip_bfloat16;
using bf16x8=__attribute__((ext_vector_type(8)))short;
using s16x4=__attribute__((ext_vector_type(4)))short;
using f32x16=__attribute__((ext_vector_type(16)))float;
using u32x4=__attribute__((ext_vector_type(4)))unsigned;
constexpr int NW=8,QBLK=32,QB=QBLK*NW,KVBLK=64;
constexpr int PQ=768,PK=1024,PV=512,PO=KCAT;
__device__ __forceinline__ int crow(int r,int hi){return (r&3)+8*(r>>2)+4*hi;}
#define SBAR() __builtin_amdgcn_sched_barrier(0)
constexpr int NSLOT=3, NKSLOT=4, SLOTB=8192, KSLOTB=16384;
constexpr int LDS_K=0, LDS_V=NKSLOT*KSLOTB, LDS_WS=LDS_V+NSLOT*SLOTB, LDS_OST=LDS_WS+NW*64*4, LDS_BYTES=LDS_OST+NW*4096;
constexpr float C2=0.10206207261596575f*1.4426950408889634f;
__device__ __forceinline__ void glds16(const void*gsrc,unsigned lds_dst){unsigned keep;
  asm volatile("s_mov_b32 %0, m0\n\ts_mov_b32 m0, %2\n\ts_nop 0\n\tglobal_load_lds_dwordx4 %1, off\n\ts_mov_b32 m0, %0":"=&s"(keep):"v"(gsrc),"s"(lds_dst):"memory");}
__device__ __forceinline__ float max3f(float a,float b,float c){float r;asm("v_max3_f32 %0, %1, %2, %3":"=v"(r):"v"(a),"v"(b),"v"(c));return r;}
__device__ __forceinline__ float max2f(float a,float b){float r;asm("v_max_f32_e32 %0, %1, %2":"=v"(r):"v"(a),"v"(b));return r;}
typedef float f32x2_t __attribute__((ext_vector_type(2))); typedef __bf16 bf16x2_t __attribute__((ext_vector_type(2)));
__device__ __forceinline__ unsigned cvtpk_s(float lo,float hi){f32x2_t v={lo,hi};bf16x2_t b=__builtin_convertvector(v,bf16x2_t);return __builtin_bit_cast(unsigned,b);}
#define WAIT_BAR(N) asm volatile("s_waitcnt vmcnt(" #N ") lgkmcnt(0)\n\ts_barrier":::"memory")
__device__ __forceinline__ void qkt(f32x16&p0,f32x16&p1,const char*Kslot,const bf16x8*qr,int r32,int hi){
  const char*kb=Kslot+hi*1024+r32*16; const f32x16 z=f32x16{};
  #pragma unroll
  for(int d0=0;d0<6;++d0){
    const bf16x8 b0=*reinterpret_cast<const bf16x8*>(kb+d0*2048);
    const bf16x8 b1=*reinterpret_cast<const bf16x8*>(kb+d0*2048+512);
    if(d0==0){p0=__builtin_amdgcn_mfma_f32_32x32x16_bf16(b0,qr[0],z,0,0,0);p1=__builtin_amdgcn_mfma_f32_32x32x16_bf16(b1,qr[0],z,0,0,0);}
    else{p0=__builtin_amdgcn_mfma_f32_32x32x16_bf16(b0,qr[d0],p0,0,0,0);p1=__builtin_amdgcn_mfma_f32_32x32x16_bf16(b1,qr[d0],p1,0,0,0);}}
}
typedef __attribute__((address_space(3))) const char* lds_cptr;
typedef short v4i16_t __attribute__((ext_vector_type(4)));
__device__ __forceinline__ void kload2(bf16x8*kf,lds_cptr kp,int j){ kf[2*j]=*(const __attribute__((address_space(3))) bf16x8*)(kp+j*2048); kf[2*j+1]=*(const __attribute__((address_space(3))) bf16x8*)(kp+j*2048+512); }
__device__ __forceinline__ s16x4 vtr(lds_cptr p){ return __builtin_bit_cast(s16x4,__builtin_amdgcn_ds_read_tr16_b64_v4i16((__attribute__((address_space(3))) v4i16_t*)p)); }
__device__ __forceinline__ float rowmax(const f32x16&p0,const f32x16&p1){
  float a=max3f(p0[0],p0[1],p1[0]),b=max3f(p0[2],p0[3],p1[1]);a=max3f(a,p1[2],p1[3]);
  #pragma unroll
  for(int r=4;r<16;r+=4){a=max3f(a,p0[r],p0[r+1]);b=max3f(b,p0[r+2],p0[r+3]);a=max3f(a,p1[r],p1[r+1]);b=max3f(b,p1[r+2],p1[r+3]);}
  const float m=max2f(a,b);
  auto rr=__builtin_amdgcn_permlane32_swap(__float_as_uint(m),__float_as_uint(m),false,false);
  return max2f(__uint_as_float(rr[0]),__uint_as_float(rr[1]));
}
__device__ __forceinline__ void pv(f32x16*o,int vb,bf16x8 pa0,bf16x8 pa1,bf16x8 pa2,bf16x8 pa3){
  #pragma unroll
  for(int d0=0;d0<2;++d0){s16x4 lo[4],hi[4];
    #pragma unroll
    for(int ks=0;ks<4;++ks){
      asm volatile("ds_read_b64_tr_b16 %0,%1 offset:%c2":"=&v"(lo[ks]):"v"(vb),"i"(d0*4096+ks*1024):"memory");
      asm volatile("ds_read_b64_tr_b16 %0,%1 offset:%c2":"=&v"(hi[ks]):"v"(vb),"i"(d0*4096+ks*1024+512):"memory");}
    asm volatile("s_waitcnt lgkmcnt(0)":::"memory");SBAR();
    #define PK(k) (bf16x8){lo[k][0],lo[k][1],lo[k][2],lo[k][3],hi[k][0],hi[k][1],hi[k][2],hi[k][3]}
    o[d0]=__builtin_amdgcn_mfma_f32_32x32x16_bf16(pa0,PK(0),o[d0],0,0,0);
    o[d0]=__builtin_amdgcn_mfma_f32_32x32x16_bf16(pa1,PK(1),o[d0],0,0,0);
    o[d0]=__builtin_amdgcn_mfma_f32_32x32x16_bf16(pa2,PK(2),o[d0],0,0,0);
    o[d0]=__builtin_amdgcn_mfma_f32_32x32x16_bf16(pa3,PK(3),o[d0],0,0,0);
    #undef PK
  }
}
template<int THRL> __device__ __forceinline__ void attn_unit(int b,int h,int qb,const bf16*Q,const bf16*__restrict__ K,const bf16*__restrict__ V,bf16*O,char*shm,const int wid){
  int lane=lane_id(); asm volatile("":"+v"(lane));
  const int r32=lane&31,hi=lane>>5;
  const long rowbase=(long)b*SEQ; const int q0=qb*QB;
  const bf16*Qw=Q+(rowbase+q0+wid*QBLK)*PQ+h*96;
  const bf16*Kh=K+rowbase*PK+h*128,*Vh=V+rowbase*PV+h*64;
  const unsigned lds0=(unsigned)(uintptr_t)shm;
  float*wsf=(float*)(shm+LDS_WS)+wid*64;
  const bf16*ksrc=Kh+(long)lane*PK+wid*8;
  const bf16*vsrc=Vh+(long)(16*(wid&3)+(lane>>2))*PV+(wid>>2)*32+(lane&3)*8;
  const unsigned kdst=lds0+LDS_K+wid*1024, vdst=lds0+LDS_V+wid*1024;
  #define DMA_K(t,slot) do{ glds16(ksrc+(long)(t)*KVBLK*PK,(unsigned)__builtin_amdgcn_readfirstlane(kdst+(slot))); if(wid<4){ glds16(ksrc+64+(long)(t)*KVBLK*PK,(unsigned)__builtin_amdgcn_readfirstlane(kdst+8192+(slot))); } }while(0)
  #define WAIT_BARW(A,B) do{ if(wid<4){WAIT_BAR(A);}else{WAIT_BAR(B);} }while(0)
  #define DMA_V(t,slot) glds16(vsrc+(long)(t)*KVBLK*PV,(unsigned)__builtin_amdgcn_readfirstlane(vdst+(slot)))
  const int vb0=(int)(lds0+LDS_V)+((lane>>4)&1)*32+(lane&3)*8+(4*hi+((lane&15)>>2))*64;
  const char*Kbase=shm+LDS_K; bf16x8 kf[12];
  const lds_cptr shm3=(lds_cptr)shm; const lds_cptr kp0=shm3+LDS_K+hi*1024+r32*16; const lds_cptr vp0=shm3+LDS_V+((lane>>4)&1)*32+(lane&3)*8+(4*hi+((lane&15)>>2))*64;
  const int NT=(q0+QB)/KVBLK;
  DMA_K(0,0);DMA_V(0,0);DMA_K(1,KSLOTB);
  bf16x8 qr[6];
  #pragma unroll
  for(int d0=0;d0<6;++d0)qr[d0]=*reinterpret_cast<const bf16x8*>(&Qw[(long)r32*PQ+d0*16+hi*8]);
  float mhat=0.f,l_reg=0.f;f32x16 o[2];o[0]=f32x16{};o[1]=f32x16{};
#if ATT_NEGM
  f32x16 negm;
#endif
  const int wchunk=wid>>1;
  #define CMASK(P0,P1,t) do{int jb_=(t)-(NT-4); if(jb_>wchunk){ _Pragma("unroll") for(int r=0;r<16;++r){P0[r]=-INFINITY;P1[r]=-INFINITY;} } }while(0)
  bool resc=false;
  #define RESC() do{ if(resc){ asm volatile("s_waitcnt lgkmcnt(0)":::"memory"); \
      _Pragma("unroll") for(int d_=0;d_<2;++d_) _Pragma("unroll") for(int r=0;r<16;++r)o[d_][r]*=wsf[crow(r,hi)]; } }while(0)
  f32x16 pA0,pA1,pB0,pB1;
  int sl_prev=0,sl_cur=0,sl_next=SLOTB, kq_prev=0,kq_cur=0,kq_next=KSLOTB;
  const int grp=wid>>2;
  #define ROT() do{sl_prev=sl_cur;sl_cur=sl_next;sl_next=(sl_next==(NSLOT-1)*SLOTB)?0:sl_next+SLOTB; kq_prev=kq_cur;kq_cur=kq_next;kq_next=(kq_next==(NKSLOT-1)*KSLOTB)?0:kq_next+KSLOTB;}while(0)
  DMA_K(2,2*KSLOTB);
  WAIT_BARW(5,4);
  qkt(pA0,pA1,Kbase,qr,r32,hi);asm volatile("s_nop 15\n\ts_nop 7":"+v"(pA0),"+v"(pA1));
  { const float rm=rowmax(pA0,pA1); mhat=rm;
    _Pragma("unroll") for(int r=0;r<16;++r)pA0[r]=__builtin_amdgcn_exp2f(pA0[r]-mhat);
    _Pragma("unroll") for(int r=0;r<16;++r)pA1[r]=__builtin_amdgcn_exp2f(pA1[r]-mhat);
#if ATT_NEGM
    _Pragma("unroll") for(int r=0;r<16;++r)negm[r]=-mhat; asm volatile("":"+v"(negm));
#endif
  }
  WAIT_BAR(0);
  DMA_K(3,3*KSLOTB);DMA_V(1,SLOTB);
  ROT();
  #pragma unroll
  for(int j=0;j<6;++j)kload2(kf,kp0+kq_cur,j);
  WAIT_BARW(3,2);
  s16x4 vlo[8],vhi[8]; u32x4 pw0,pw1,pw2,pw3;
  #define PKW(P,B) cvtpk_s(P[B],P[B+1])
  #define PAF(k) __builtin_bit_cast(bf16x8,pw##k)
  #define VFR(i) (bf16x8){vlo[i][0],vlo[i][1],vlo[i][2],vlo[i][3],vhi[i][0],vhi[i][1],vhi[i][2],vhi[i][3]}
  #define PIN(x) asm volatile("":"+v"(x))
  #define MX3(a,b,c) __builtin_fmaxf(__builtin_fmaxf((a),(b)),(c))
  #define GAPA(MF,A0,A1,A2,A3,W0,W1,PW) do{ MF; sacc+=A0; sacc+=A1; sacc+=A2; sacc+=A3; PIN(sacc); W0; W1; PIN(PW); SBAR(); }while(0)
  #define GAPA2(MF,A0,A1,W0,W1,PW) do{ MF; sacc+=A0; sacc+=A1; PIN(sacc); W0; W1; PIN(PW); SBAR(); }while(0)
  #define GAPA4(MF,A0,A1,A2,A3) do{ MF; sacc+=A0; sacc+=A1; sacc+=A2; sacc+=A3; PIN(sacc); SBAR(); }while(0)
#if ATT_NEGM
  #define EX(v) __builtin_amdgcn_exp2f(v)
  #define CINIT negm
#else
  #define EX(v) __builtin_amdgcn_exp2f((v)-mhat)
  #define CINIT z_
#endif
  #define GAPB(MF,X,B) do{ MF; X[B]=EX(X[B]); X[B+1]=EX(X[B+1]); X[B+2]=EX(X[B+2]); X[B+3]=EX(X[B+3]); PIN(X); SBAR(); }while(0)
  #define VRD(i) do{ vlo[i]=vtr(vp_+(((i)>>2)*4096+((i)&3)*1024)); vhi[i]=vtr(vp_+(((i)>>2)*4096+((i)&3)*1024+512)); }while(0)
  #define KRD(G,j) do{ if(G){ kload2(kf,kp0+kq_next,j); SBAR(); } }while(0)
  #define MF_(C,kk,qq,IN) C=__builtin_amdgcn_mfma_f32_32x32x16_bf16(kf[kk],qr[qq],IN,0,0,0)
#if ATT_NEGM
  #define RMREL(rm) do{}while(0)
  #define NEGM_UPD(C0,C1,dl) do{ _Pragma("unroll") for(int r=0;r<16;++r){C0[r]-=dl;C1[r]-=dl;} _Pragma("unroll") for(int r=0;r<16;++r)negm[r]=-mhat; asm volatile("":"+v"(negm)); }while(0)
#else
  #define RMREL(rm) rm-=mhat
  #define NEGM_UPD(C0,C1,dl) do{}while(0)
#endif
  #define STEP(C0,C1,P0,P1,t,GK,GV,GL,MK,MIDW) do{ SBAR(); \
    const lds_cptr vp_=vp0+sl_prev; const f32x16 z_=f32x16{}; \
    VRD(0); SBAR(); float sacc=(P0[0]+P0[1]); \
    GAPA2(MF_(C0,0,0,CINIT), P0[2],P0[3],     pw0[0]=PKW(P0,0), pw0[1]=PKW(P0,2), pw0); \
    VRD(4); SBAR(); GAPA2(MF_(C1,1,0,CINIT), P0[4],P0[5],     pw0[2]=PKW(P0,4), pw0[3]=PKW(P0,6), pw0); \
    VRD(1); SBAR(); GAPA2(MF_(C0,2,1,C0),   P0[6],P0[7], pw1[0]=PKW(P0,8), pw1[1]=PKW(P0,10), pw1); \
    VRD(5); SBAR(); GAPA2(MF_(C1,3,1,C1),   P0[8],P0[9],   pw1[2]=PKW(P0,12),pw1[3]=PKW(P0,14), pw1); \
    VRD(2); SBAR(); GAPA2(MF_(C0,4,2,C0),   P0[10],P0[11],     pw2[0]=PKW(P1,0), pw2[1]=PKW(P1,2), pw2); \
    VRD(6); SBAR(); GAPA2(MF_(C1,5,2,C1),   P0[12],P0[13],     pw2[2]=PKW(P1,4), pw2[3]=PKW(P1,6), pw2); \
    VRD(3); SBAR(); GAPA2(MF_(C0,6,3,C0),   P0[14],P0[15], pw3[0]=PKW(P1,8), pw3[1]=PKW(P1,10), pw3); \
    VRD(7); SBAR(); GAPA2(MF_(C1,7,3,C1),   P1[0],P1[1],       pw3[2]=PKW(P1,12),pw3[3]=PKW(P1,14), pw3); \
    GAPA4(MF_(C0,8,4,C0), P1[2],P1[3],P1[4],P1[5]); GAPA4(MF_(C1,9,4,C1), P1[6],P1[7],P1[8],P1[9]); GAPA4(MF_(C0,10,5,C0), P1[10],P1[11],P1[12],P1[13]); GAPA4(MF_(C1,11,5,C1), P1[14],P1[15],0.f,0.f); \
    l_reg+=sacc; \
    if(GK){DMA_K((t)+3,kq_prev);} if(GV){DMA_V((t)+1,sl_next);} \
    if(MK){CMASK(C0,C1,t);} \
    { float a=MX3(C0[0],C0[1],C1[0]),b=MX3(C0[2],C0[3],C1[1]); a=MX3(a,C1[2],C1[3]); \
      _Pragma("unroll") for(int r=4;r<16;r+=4){a=MX3(a,C0[r],C0[r+1]);b=MX3(b,C0[r+2],C0[r+3]);a=MX3(a,C1[r],C1[r+1]);b=MX3(b,C1[r+2],C1[r+3]);} \
      float rm=__builtin_fmaxf(a,b); { auto rr=__builtin_amdgcn_permlane32_swap(__float_as_uint(rm),__float_as_uint(rm),false,false); rm=__builtin_fmaxf(__uint_as_float(rr[0]),__uint_as_float(rr[1])); } \
      RMREL(rm); resc=false; \
      if(__builtin_expect(__any(rm>(float)THRL),0)){ const float dl=__builtin_fmaxf(rm,0.f); mhat+=dl; NEGM_UPD(C0,C1,dl); \
        const float f=__builtin_amdgcn_exp2f(-dl); l_reg*=f; if(hi==0)wsf[r32]=f; resc=true; } } \
    SBAR(); MIDW; SBAR(); \
    GAPB(o[0]=__builtin_amdgcn_mfma_f32_32x32x16_bf16(PAF(0),VFR(0),o[0],0,0,0), C0,0); \
    GAPB(o[1]=__builtin_amdgcn_mfma_f32_32x32x16_bf16(PAF(0),VFR(4),o[1],0,0,0), C0,4); \
    KRD(GL,0); GAPB(o[0]=__builtin_amdgcn_mfma_f32_32x32x16_bf16(PAF(1),VFR(1),o[0],0,0,0), C0,8); \
    KRD(GL,1); GAPB(o[1]=__builtin_amdgcn_mfma_f32_32x32x16_bf16(PAF(1),VFR(5),o[1],0,0,0), C0,12); \
    KRD(GL,2); GAPB(o[0]=__builtin_amdgcn_mfma_f32_32x32x16_bf16(PAF(2),VFR(2),o[0],0,0,0), C1,0); \
    KRD(GL,3); GAPB(o[1]=__builtin_amdgcn_mfma_f32_32x32x16_bf16(PAF(2),VFR(6),o[1],0,0,0), C1,4); \
    KRD(GL,4); GAPB(o[0]=__builtin_amdgcn_mfma_f32_32x32x16_bf16(PAF(3),VFR(3),o[0],0,0,0), C1,8); \
    KRD(GL,5); GAPB(o[1]=__builtin_amdgcn_mfma_f32_32x32x16_bf16(PAF(3),VFR(7),o[1],0,0,0), C1,12); \
    }while(0)
  int t=1;
  for(;t+3<NT;t+=2){
    STEP(pB0,pB1,pA0,pA1,t,true,true,true,false,if(grp){WAIT_BAR(2);});     if(!grp){WAIT_BAR(3);} RESC(); ROT();
    STEP(pA0,pA1,pB0,pB1,t+1,true,true,true,false,if(grp){WAIT_BAR(2);});   if(!grp){WAIT_BAR(3);} RESC(); ROT();
  }
  STEP(pB0,pB1,pA0,pA1,t,false,true,true,true,if(grp){WAIT_BAR(1);});       if(!grp){WAIT_BAR(1);} RESC(); ROT();
  STEP(pA0,pA1,pB0,pB1,t+1,false,true,true,true,if(grp){WAIT_BAR(0);});     if(!grp){WAIT_BAR(0);} RESC(); ROT();
  STEP(pB0,pB1,pA0,pA1,NT-1,false,false,false,true,(void)0); RESC();
  { float sacc=pB0[0]+pB0[1]; _Pragma("unroll") for(int r=2;r<16;++r)sacc+=pB0[r]; _Pragma("unroll") for(int r=0;r<16;++r)sacc+=pB1[r]; l_reg+=sacc;
    pw0=(u32x4){PKW(pB0,0),PKW(pB0,2),PKW(pB0,4),PKW(pB0,6)};pw1=(u32x4){PKW(pB0,8),PKW(pB0,10),PKW(pB0,12),PKW(pB0,14)};pw2=(u32x4){PKW(pB1,0),PKW(pB1,2),PKW(pB1,4),PKW(pB1,6)};pw3=(u32x4){PKW(pB1,8),PKW(pB1,10),PKW(pB1,12),PKW(pB1,14)};
    SBAR(); pv(o,vb0+sl_cur,PAF(0),PAF(1),PAF(2),PAF(3)); }
  {auto rr=__builtin_amdgcn_permlane32_swap(__float_as_uint(l_reg),__float_as_uint(l_reg),false,false);l_reg=__uint_as_float(rr[0])+__uint_as_float(rr[1]);}
  if(hi==0)wsf[32+r32]=l_reg;asm volatile("s_waitcnt lgkmcnt(0)":::"memory");
  float rli[16];
  #pragma unroll
  for(int r=0;r<16;++r)rli[r]=__builtin_amdgcn_rcpf(wsf[32+crow(r,hi)]);
  bf16*Ow=O+(rowbase+q0+wid*QBLK)*PO+F_MLA+h*64;
  { bf16*stg=(bf16*)(shm+LDS_OST)+wid*2048;
    #pragma unroll
    for(int r=0;r<16;++r){const int orow=crow(r,hi);
      #pragma unroll
      for(int d0=0;d0<2;++d0)stg[orow*64+d0*32+r32]=__float2bfloat16(o[d0][r]*rli[r]);}
    asm volatile("s_waitcnt lgkmcnt(0)":::"memory");
    #pragma unroll
    for(int i=0;i<4;++i){const int row=i*8+(lane>>3),ch=lane&7; const u32x4 v=*(const u32x4*)(stg+row*64+ch*8); *(u32x4*)(Ow+(long)row*PO+ch*8)=v;} }
  asm volatile("s_waitcnt lgkmcnt(0)\n\ts_barrier":::"memory");
  #undef DMA_K
  #undef WAIT_BARW
  #undef DMA_V
  #undef CMASK
  #undef RESC
  #undef ROT
  #undef PKW
  #undef PAF
  #undef VFR
  #undef PIN
  #undef MX3
  #undef GAPA
  #undef GAPA2
  #undef GAPA4
  #undef EX
  #undef GAPB
  #undef VRD
  #undef KRD
  #undef MF_
  #undef STEP
  #undef EX
  #undef CINIT
  #undef RMREL
  #undef NEGM_UPD
}
#undef SBAR
#undef WAIT_BAR
}

constexpr size_t MiB = 1u << 20;
constexpr size_t WS_CTL = 0, CTL_ZERO_BYTES = 256 * 1024;
constexpr int XLD = 1280;
constexpr size_t SZ_WIN = (size_t)NZ * XLD * 2, SZ_WCAT = (size_t)DM * KCAT * 2, SZ_WO = (size_t)DM * DM * 2, SZ_WUQ = (size_t)768 * 256 * 2, SZ_WUKV = (size_t)1024 * 256 * 2;
constexpr size_t WS_STV = 512 * 1024;
constexpr size_t WS_TOK = 1 * MiB;
constexpr size_t WS_SSQ = WS_TOK + 384 * 1024;
constexpr size_t WS_SSK = WS_SSQ + 256 * 1024;
constexpr size_t WS_MGU = 2 * MiB;
constexpr size_t SZ_MGU = (size_t)2 * DFFE * DM * 2, SZ_MD = (size_t)DM * DFFE * 2;
constexpr size_t WS_MD = WS_MGU + 8 * SZ_MGU;
constexpr size_t SZ_MGU8 = (size_t)2 * DFFE * DM;
constexpr size_t WS_XRB = WS_MGU + 56 * MiB;
static_assert(8 * SZ_MGU8 <= 56 * MiB && WS_XRB + (size_t)16384 * 1024 * 2 <= WS_MD, "xrb");
constexpr size_t WS_A0 = WS_MD + 8 * SZ_MD;
static_assert(WS_A0 == 170 * MiB && WS_SSK + 256 * 1024 <= WS_MGU, "map");
constexpr size_t WS_XP = WS_A0;
constexpr size_t WS_HC = WS_A0 + 68 * MiB;
constexpr size_t WS_XN = WS_A0;
constexpr size_t WS_F = WS_A0 + 40 * MiB;
constexpr size_t WS_GS = WS_A0 + 80 * MiB;
constexpr size_t WS_U = WS_A0 + 96 * MiB;
constexpr size_t WS_ZP = WS_A0 + 104 * MiB;
constexpr size_t WS_ZKV = WS_A0 + 112 * MiB;
constexpr size_t WS_ZQ = WS_A0 + 120 * MiB;
constexpr size_t WS_KVRAW = WS_A0 + 128 * MiB;
constexpr size_t WS_QRAW = WS_A0 + 160 * MiB;
constexpr size_t WS_MG = WS_A0 + 184 * MiB;
constexpr size_t WS_TG = WS_A0 + 216 * MiB;
constexpr size_t WS_VB = WS_TG;
constexpr size_t WS_KF = WS_KVRAW;
constexpr size_t WS_KR = WS_A0 + 248 * MiB;
constexpr size_t WS_SXN = 478 * MiB;
constexpr size_t WS_SWGU0 = WS_SXN + 64 * 1024;
constexpr size_t WS_SWIN = WS_SWGU0 + 32 * 1024;
constexpr size_t WS_SWMOE = WS_SWIN + 64 * 1024;
constexpr size_t WS_SXP = WS_SWMOE + 256 * 1024;
constexpr size_t WS_SXQ = WS_SXP + 160 * 1024;
constexpr size_t WS_TIX = WS_SXQ + 64 * 1024;
static_assert(WS_TIX + (size_t)8 * 16384 * 4 <= 523801632ull, "tix");
constexpr size_t WS_XNQ = WS_A0 + 80 * MiB;
constexpr size_t WS_XN2 = WS_A0;
static_assert(WS_XN2 + (size_t)16384 * 2560 <= WS_HC, "XN2 must not overlap the MoE hidden buffer");
constexpr size_t WS_H = WS_A0 + 80 * MiB;
constexpr size_t WS_WIN = 420 * MiB;
constexpr size_t WS_WCAT = WS_WIN + 2 * SZ_WIN;
constexpr size_t WS_WO = WS_WCAT + 2 * SZ_WCAT;
constexpr size_t WS_WUQ = WS_WO + 2 * SZ_WO;
constexpr size_t WS_WUKV = WS_WUQ + 2 * SZ_WUQ;
constexpr size_t WS_WGU0 = WS_WUKV + 2 * SZ_WUKV;
constexpr size_t WS_WD0 = WS_WGU0 + (size_t)2 * DFF * DM * 2;
constexpr size_t WS_CS = WS_WD0 + (size_t)DM * DFF * 2;
constexpr size_t WS_END = WS_CS + (size_t)SEQ * 32 * 4;
static_assert(WS_END <= WS_SXN && WS_SXQ + (size_t)M * 4 <= 523801632ull && WS_HC + (size_t)MOE_TILES_MAX * 256 * DFFE * 2 <= WS_SXN, "scale block");
constexpr size_t WS_YF = WS_MGU;
static_assert(WS_YF + 56 * MiB <= WS_MD, "YF");
static_assert(WS_KR + (size_t)M * 32 * 2 <= WS_WIN && WS_H + (size_t)M * DFF * 2 <= WS_MG, "layer buffers");
static_assert(WS_HC + (size_t)MOE_TILES_MAX * 256 * DFFE * 2 <= 523801632ull, "moe map");
static_assert(WS_END <= 523801632ull, "d_ws budget");
constexpr int CW_CK = 16384;
constexpr int CW_TMO = 0, CW_CODE = 1, CW_BAR = 4096, CW_MOE = 8192;

constexpr int RING_BYTES = 131072, LDSCTL_OFF = RING_BYTES, MISC_OFF = LDSCTL_OFF + 320, LDS_BYTES = 147456;

#define GAS __attribute__((address_space(1)))
#define LAS __attribute__((address_space(3)))
typedef unsigned short bf16;
typedef unsigned v4u __attribute__((ext_vector_type(4)));
typedef unsigned v2u __attribute__((ext_vector_type(2)));
typedef float f32x4 __attribute__((ext_vector_type(4)));
typedef GAS unsigned gu32;
#define RLX_AGENT __ATOMIC_RELAXED, __HIP_MEMORY_SCOPE_AGENT
#define LDS_WAIT() asm volatile("s_waitcnt lgkmcnt(0)" ::: "memory")
#define VM_WAIT() asm volatile("s_waitcnt vmcnt(0)" ::: "memory")
__device__ __forceinline__ unsigned pk2(float lo, float hi) { return pg8::cvt_pk_bf16(lo, hi); }
__device__ __forceinline__ float bflo(unsigned w) { return __uint_as_float(w << 16); }
__device__ __forceinline__ float bfhi(unsigned w) { return __uint_as_float(w & 0xffff0000u); }
__device__ __forceinline__ float sigmoidf_(float x) { return __builtin_amdgcn_rcpf(1.0f + __builtin_amdgcn_exp2f(-1.4426950408889634f * x)); }
__device__ __forceinline__ float gelu_erf(float x) { return 0.5f * x * (1.0f + erff(x * 0.70710678118654752f)); }

#define XB_TMO      128
#define XB_XCNT(j)  (256  + 64 * (j))
#define XB_XSUB(j)  (1280 + 64 * (j))
#define XB_XGEN(j)  (2304 + 64 * (j))
#define XB_TOP      3328
#define XB_TOPGEN   3392
#define XCD_BAR_WORDS 3456
#define XB_SPIN_CAP (1u << 18)
__device__ __forceinline__ unsigned xb_ld(unsigned* p)              { return __hip_atomic_load(p, __ATOMIC_RELAXED, __HIP_MEMORY_SCOPE_AGENT); }
__device__ __forceinline__ unsigned xb_add(unsigned* p, unsigned v) { return __hip_atomic_fetch_add(p, v, __ATOMIC_RELAXED, __HIP_MEMORY_SCOPE_AGENT); }
__device__ __forceinline__ unsigned xb_xcc_id() { return (unsigned)__builtin_amdgcn_s_getreg((3 << 11) | 20) & 0xFu; }
#define XB_SPIN(cond, bar) do { unsigned _sp = 0; while (cond) { __builtin_amdgcn_s_sleep(1); \
    if ((++_sp & 255u) == 0u) { if (xb_ld(&(bar)[XB_TMO])) break; if (_sp > XB_SPIN_CAP) { atomicAdd(&(bar)[XB_TMO], 1u); break; } } } } while (0)
struct XcdBarrier { unsigned* bar; unsigned x; volatile LAS unsigned* st; int wave; };
__device__ __forceinline__ XcdBarrier xcd_barrier_post(unsigned* bar, volatile LAS unsigned* st) {
    XcdBarrier b; b.bar = bar; b.x = xb_xcc_id(); b.st = st;
    if (threadIdx.x == 0) (void)xb_add(&bar[XB_XCNT(b.x)], 1u);
    return b;
}
__device__ __forceinline__ void xcd_barrier_complete(unsigned* bar, unsigned x, unsigned& nloc, unsigned& nx) {
    const unsigned G = gridDim.x * gridDim.y * gridDim.z;
    unsigned sum, cnt, mine, sp = 0u;
    for (;;) {
        sum = 0u; cnt = 0u; mine = 0u;
#pragma unroll
        for (unsigned j = 0; j < 16; ++j) { const unsigned c = xb_ld(&bar[XB_XCNT(j)]); sum += c; cnt += (c > 0u) ? 1u : 0u; mine = (j == x) ? c : mine; }
        if (sum == G) break;
        __builtin_amdgcn_s_sleep(1);
        if ((++sp & 255u) == 0u) { if (xb_ld(&bar[XB_TMO])) break; if (sp > XB_SPIN_CAP) { atomicAdd(&bar[XB_TMO], 1u); break; } }
    }
    nloc = mine > 0u ? mine : 1u; nx = cnt > 0u ? cnt : 1u;
}
__device__ __forceinline__ void xcd_barrier(const XcdBarrier& b) {
    asm volatile("s_waitcnt vmcnt(0)" ::: "memory");
    __syncthreads();
    if (b.wave == 0 && lane_id() == 0) {
        unsigned* bar = b.bar;
        __builtin_amdgcn_s_waitcnt(0);
        unsigned nloc = b.st[0], nx = b.st[1];
        if (nloc == 0u) { xcd_barrier_complete(bar, b.x, nloc, nx); b.st[0] = nloc; b.st[1] = nx; }
        const unsigned old = xb_add(&bar[XB_XSUB(b.x)], 1u);
        const unsigned gen = old / nloc;
        if (old + 1u == (gen + 1u) * nloc) {
            __builtin_amdgcn_fence(__ATOMIC_RELEASE, "agent");
            asm volatile("s_waitcnt vmcnt(0)" ::: "memory");
            const unsigned og = xb_add(&bar[XB_TOP], 1u);
            const unsigned tg = og / nx;
            if (og + 1u == (tg + 1u) * nx) xb_add(&bar[XB_TOPGEN], 1u);
            else XB_SPIN(xb_ld(&bar[XB_TOPGEN]) == tg, bar);
            __builtin_amdgcn_fence(__ATOMIC_ACQUIRE, "agent");
            xb_add(&bar[XB_XGEN(b.x)], 1u);
            asm volatile("s_waitcnt vmcnt(0)" ::: "memory");
        } else {
            XB_SPIN(xb_ld(&bar[XB_XGEN(b.x)]) == gen, bar);
            __builtin_amdgcn_fence(__ATOMIC_ACQUIRE, "agent");
            asm volatile("s_waitcnt vmcnt(0)" ::: "memory");
        }
    }
    __syncthreads();
}

__device__ __forceinline__ float wave_sum(float v) {
#pragma unroll
    for (int o = 1; o < 64; o <<= 1) v += __shfl_xor(v, o);
    return v;
}

__device__ __forceinline__ float wave_max(float v) {
#pragma unroll
    for (int o = 1; o < 64; o <<= 1) v = fmaxf(v, __shfl_xor(v, o));
    return v;
}
constexpr float F8_SA = 8.0f, F8_SWU = 32.0f;
constexpr float F8_SY = 16.0f;
constexpr float F8_SH = 8.0f, F8_SW = 64.0f;
__device__ __forceinline__ unsigned f8x4(float a, float b, float c, float d) { unsigned w = 0u; w = __builtin_amdgcn_cvt_pk_fp8_f32(a, b, w, false); w = __builtin_amdgcn_cvt_pk_fp8_f32(c, d, w, true); return w; }
__device__ __forceinline__ unsigned q8x4(float a, float b, float c, float d, float inv) {
    const int qa = (int)rintf(a * inv), qb = (int)rintf(b * inv), qc = (int)rintf(c * inv), qd = (int)rintf(d * inv);
    return (unsigned)(qa & 0xff) | ((unsigned)(qb & 0xff) << 8) | ((unsigned)(qc & 0xff) << 16) | ((unsigned)(qd & 0xff) << 24);
}
__device__ __forceinline__ void quant_rows(bf16* W, int rows, int ld, float* sw, int row_begin, int row_stride) {
    const int lane = lane_id();
    for (int r0 = row_begin; r0 < rows; r0 += 4 * row_stride) {
        v4u z0[4], z1[4];
#pragma unroll
        for (int i = 0; i < 4; ++i) { const int r = r0 + i * row_stride; if (r < rows) { const bf16* rp = W + (size_t)r * ld; z0[i] = *(const v4u*)(rp + 16 * lane); z1[i] = *(const v4u*)(rp + 16 * lane + 8); } else { z0[i] = (v4u){0u, 0u, 0u, 0u}; z1[i] = z0[i]; } }
#pragma unroll
        for (int i = 0; i < 4; ++i) { const int r = r0 + i * row_stride;
            const float x[16] = {bflo(z0[i].x), bfhi(z0[i].x), bflo(z0[i].y), bfhi(z0[i].y), bflo(z0[i].z), bfhi(z0[i].z), bflo(z0[i].w), bfhi(z0[i].w), bflo(z1[i].x), bfhi(z1[i].x), bflo(z1[i].y), bfhi(z1[i].y), bflo(z1[i].z), bfhi(z1[i].z), bflo(z1[i].w), bfhi(z1[i].w)};
            float am = 0.f;
#pragma unroll
            for (int k = 0; k < 16; ++k) am = fmaxf(am, fabsf(x[k]));
            am = wave_max(am); const float sc = am > 0.f ? am * (1.f / 127.f) : 1.f, inv = am > 0.f ? 127.f / am : 0.f;
            const v4u q = (v4u){q8x4(x[0], x[1], x[2], x[3], inv), q8x4(x[4], x[5], x[6], x[7], inv), q8x4(x[8], x[9], x[10], x[11], inv), q8x4(x[12], x[13], x[14], x[15], inv)};
            if (r < rows) { *(v4u*)((unsigned char*)(W + (size_t)r * ld) + 16 * lane) = q; if (lane == 0) sw[r] = sc; } }
    }
}
__device__ __forceinline__ void quant_copy_rows(const bf16* X, unsigned char* Q, int rows, int ld, float* sx, int row_begin, int row_stride) {
    const int lane = lane_id();
    for (int r0 = row_begin; r0 < rows; r0 += 4 * row_stride) {
        v4u z0[4], z1[4];
#pragma unroll
        for (int i = 0; i < 4; ++i) { const int r = r0 + i * row_stride; if (r < rows) { const bf16* rp = X + (size_t)r * ld; z0[i] = *(const v4u*)(rp + 16 * lane); z1[i] = *(const v4u*)(rp + 16 * lane + 8); } else { z0[i] = (v4u){0u, 0u, 0u, 0u}; z1[i] = z0[i]; } }
#pragma unroll
        for (int i = 0; i < 4; ++i) { const int r = r0 + i * row_stride;
            const float x[16] = {bflo(z0[i].x), bfhi(z0[i].x), bflo(z0[i].y), bfhi(z0[i].y), bflo(z0[i].z), bfhi(z0[i].z), bflo(z0[i].w), bfhi(z0[i].w), bflo(z1[i].x), bfhi(z1[i].x), bflo(z1[i].y), bfhi(z1[i].y), bflo(z1[i].z), bfhi(z1[i].z), bflo(z1[i].w), bfhi(z1[i].w)};
            float am = 0.f;
#pragma unroll
            for (int k = 0; k < 16; ++k) am = fmaxf(am, fabsf(x[k]));
            am = wave_max(am); const float sc = am > 0.f ? am * (1.f / 127.f) : 1.f, inv = am > 0.f ? 127.f / am : 0.f;
            const v4u q = (v4u){q8x4(x[0], x[1], x[2], x[3], inv), q8x4(x[4], x[5], x[6], x[7], inv), q8x4(x[8], x[9], x[10], x[11], inv), q8x4(x[12], x[13], x[14], x[15], inv)};
            if (r < rows) { *(v4u*)(Q + (size_t)r * ld * 2 + 16 * lane) = q; if (lane == 0) sx[r] = sc; } }
    }
}
constexpr int SC_LDS_OFF = 132096;
extern __shared__ __attribute__((aligned(16))) unsigned char dyn_lds_all[];
__device__ __forceinline__ const LAS float* park_scales(float pfv, int tid) {
    LAS float* tb = (LAS float*)((LAS unsigned char*)dyn_lds_all + SC_LDS_OFF);
    tb[tid] = pfv;
    asm volatile("s_waitcnt lgkmcnt(0)" ::: "memory"); __builtin_amdgcn_s_barrier(); asm volatile("" ::: "memory");
    return tb;
}
struct TileOrder {
    pg8::StaticOrder so; const char* A; const char* B; size_t a_tile, b_tile; int nt;
    __device__ __forceinline__ bool next(int i, pg8::Unit& u) const {
        int pm, pn; if (!so.tile(i, pm, pn)) return false;
        u.pm = pm; u.pn = pn; u.nt = nt; u.aux = 0; u.A = A + (size_t)pm * a_tile; u.B = B + (size_t)pn * b_tile; return true; }
};
struct WinOrder {
    int c, G; const char* A; const char* B; size_t a_tile, b_tile; int nt;
    __device__ __forceinline__ bool next(int i, pg8::Unit& u) const {
        int rt, pn;
        if (G == 256) { const int x = c & 7, j = c >> 3;
            if (i == 0) { if (j < 16) { rt = 8 * x + (j >> 1); pn = 5 + (j & 1); } else { rt = 8 * x + ((j - 16) >> 1); pn = 3 + (j & 1); } }
            else if (i == 1) { int t; if (j >= 16) t = j - 16; else if (j < 8) t = 16 + j; else return false; rt = 8 * x + t / 3; pn = t % 3; }
            else return false;
        } else { const long L = (long)i * G + c; if (L >= 64 * 7) return false; rt = (int)(L / 7); pn = (int)(L % 7); }
        u.pm = rt; u.pn = pn; u.nt = nt; u.aux = 0; u.A = A + (size_t)rt * a_tile; u.B = B + (size_t)pn * b_tile; return true; }
};
struct BranchOrder {
    pg8::StaticOrder so; const char* XNp; const char* Wz; const char* Fp; const char* Wc;
    __device__ __forceinline__ bool next(int i, pg8::Unit& u) const {
        int pm, pn; if (!so.tile(i >> 3, pm, pn)) return false;
        const int sub = i & 7, br = sub >> 1, kind = sub & 1; u.pm = pm; u.pn = pn; u.aux = sub;
        if (kind == 0) { u.nt = GATE_I8 ? 8 : 16; u.A = XNp + (size_t)pm * 256 * XLD * 2; u.B = Wz + (size_t)(br * 1024 + pn * 256) * XLD * 2; }
        else { const int koff = (br == 0) ? F_POOL : (br == 1) ? F_MLA : (br == 2) ? F_CONV : F_SGU; u.nt = (br == 1) ? 8 : 4;
            u.A = Fp + ((size_t)pm * 256 * KCAT + koff) * 2; u.B = Wc + ((size_t)pn * 256 * KCAT + koff) * 2; }
        return true; }
};
struct MoeOrder {
    pg8::StaticOrder so; int nt; const char* A; const char* B; size_t a_tile, b_tile, b_exp; int toff[9]; const int* tix; int cnt[8];
    __device__ __forceinline__ bool next(int i, pg8::Unit& u) const {
        int rt, pn; if (!so.tile(i, rt, pn)) return false;
        int e = 0;
#pragma unroll
        for (int k = 1; k < 8; ++k) e += (rt >= toff[k]) ? 1 : 0;
        int t0 = 0, ce = 0;
#pragma unroll
        for (int k = 0; k < 8; ++k) { if (k == e) { t0 = toff[k]; ce = cnt[k]; } }
        const int j = rt - t0;
        u.pm = rt; u.pn = pn; u.nt = nt; u.aux = e; u.A = A; u.B = B + (size_t)e * b_exp + (size_t)pn * b_tile; u.rix = tix + (size_t)e * M + 256 * j; u.nv = ce - 256 * j; return true; }
};

struct MoeDownOrder {
    pg8::StaticOrder so; int G, c, nsub; const char* A; const char* B; size_t a_tile, b_tile, b_exp; int toff[9];
    __device__ __forceinline__ bool next(int i, pg8::Unit& u) const {
        const long L = (long)i * G + c; int rt, pn, ks = 0;
        if (L < nsub) { const int t = (int)L / 28, rem = (int)L % 28; rt = 128 + t; pn = rem / 7; ks = rem % 7; u.nt = 4; u.aux = 1 + ks; }
        else { if (!so.tileL(L - nsub, rt, pn)) return false; u.nt = DFFE / 128; u.aux = 0; }
        int e = 0;
#pragma unroll
        for (int k = 1; k < 8; ++k) e += (rt >= toff[k]) ? 1 : 0;
        u.pm = rt; u.pn = pn; u.A = A + (size_t)rt * a_tile + (size_t)ks * 4 * 128; u.B = B + (size_t)e * b_exp + (size_t)pn * b_tile + (size_t)ks * 4 * 128; return true; }
};
using pg8::Unit; typedef unsigned u32x4 __attribute__((ext_vector_type(4)));
typedef const f32x4 (&AccRef)[2][2][4][2];

typedef float f32x2 __attribute__((ext_vector_type(2)));
__device__ __forceinline__ f32x2 gelu_pk(f32x2 v) {
    const f32x2 av = __builtin_elementwise_abs(v), d = av * 0.2316418882f + 1.0f;
    f32x2 t; t.x = __builtin_amdgcn_rcpf(d.x); t.y = __builtin_amdgcn_rcpf(d.y);
    f32x2 q = t * 0.5307027145f + (-0.7265760135f); q = q * t + 0.7107068705f; q = q * t + (-0.142248368f); q = q * t + 0.127414796f; q = q * t;
    const f32x2 s = (v * v) * (-0.72134752044f);
    f32x2 e; e.x = __builtin_amdgcn_exp2f(s.x); e.y = __builtin_amdgcn_exp2f(s.y);
    const f32x2 m = v * (q * e), r = v - m;
    f32x2 o; o.x = v.x < 0.f ? m.x : r.x; o.y = v.y < 0.f ? m.y : r.y; return o;
}
__device__ __forceinline__ float xsum16(float v) { auto r = __builtin_amdgcn_permlane16_swap(__float_as_uint(v), __float_as_uint(v), false, false); return __uint_as_float(r[0]) + __uint_as_float(r[1]); }
__device__ __forceinline__ float xsum32(float v) { auto r = __builtin_amdgcn_permlane32_swap(__float_as_uint(v), __float_as_uint(v), false, false); return __uint_as_float(r[0]) + __uint_as_float(r[1]); }
__device__ __forceinline__ float xget32(float v, bool upper) { auto r = __builtin_amdgcn_permlane32_swap(__float_as_uint(v), __float_as_uint(v), false, false); return __uint_as_float(upper ? r[0] : r[1]); }
template <bool I8> struct EpiZ2T {
    static constexpr bool PERM = true;
    unsigned char* ws; const float* sx; const float* sw;
    __device__ __forceinline__ const float* pf_ptr(const Unit& u, int w) const { return w == 0 ? sx + u.pm * 256 : sw + u.pn * 256; }
    __device__ __forceinline__ void operator()(AccRef acc, const Unit& u, int wr, int wc, int fr, int fq) const { body(acc, u, wr, wc, fr, fq, nullptr); }
    __device__ __forceinline__ void operator()(AccRef acc, const Unit& u, int wr, int wc, int fr, int fq, const LAS float* sc) const { body(acc, u, wr, wc, fr, fq, sc); }
    __device__ __forceinline__ void body(AccRef acc, const Unit& u, int wr, int wc, int fr, int fq, const LAS float* sc) const {
        const int pn = u.pn; const int row0 = u.pm * 256 + wr * 64 + fr, cl = wc * 32 + 8 * fq;
        f32x4 swv[2][2];
        if (I8) {
#pragma unroll
            for (int bj = 0; bj < 2; ++bj)
#pragma unroll
                for (int n = 0; n < 2; ++n) swv[bj][n] = *(const LAS f32x4*)(sc + 256 + bj * 128 + cl + 4 * n); }
#define ZV(ai_, bj_, m_, n_) (I8 ? __builtin_convertvector(__builtin_bit_cast(pg8::i32x4, acc[ai_][bj_][m_][n_]), f32x4) * (swv[bj_][n_] * sxr) : acc[ai_][bj_][m_][n_])
        if (pn <= 2) {
            bf16* base = (bf16*)(ws + (pn == 0 ? WS_ZP : pn == 1 ? WS_ZQ : WS_ZKV));
            float* ssp = (float*)(ws + (pn == 1 ? WS_SSQ : WS_SSK));
#pragma unroll
            for (int ai = 0; ai < 2; ++ai)
#pragma unroll
                for (int m = 0; m < 4; ++m) { const int row = row0 + ai * 128 + m * 16; bf16* rowp = base + (size_t)row * 256 + cl; float ss = 0.f; const float sxr = I8 ? sc[row - u.pm * 256] : 1.f;
#pragma unroll
                    for (int bj = 0; bj < 2; ++bj) { const f32x4 v0 = ZV(ai, bj, m, 0), v1 = ZV(ai, bj, m, 1);
                        if (bj == 0 || pn == 1) ss += (v0[0] * v0[0] + v0[1] * v0[1]) + (v0[2] * v0[2] + v0[3] * v0[3]) + (v1[0] * v1[0] + v1[1] * v1[1]) + (v1[2] * v1[2] + v1[3] * v1[3]);
                        u32x4 w; w.x = pk2(v0[0], v0[1]); w.y = pk2(v0[2], v0[3]); w.z = pk2(v1[0], v1[1]); w.w = pk2(v1[2], v1[3]);
                        *(u32x4*)(rowp + bj * 128) = w; }
                    if (pn >= 1) { ss = xsum16(ss); ss = xsum32(ss); if (fq == 0) ssp[(size_t)row * 4 + wc] = ss; }
                    if (pn == 2 && wc == 0) {
                        const f32x4 v0 = ZV(ai, 1, m, 0), v1 = ZV(ai, 1, m, 1); const float x[8] = {v0[0], v0[1], v0[2], v0[3], v1[0], v1[1], v1[2], v1[3]};
                        const float* cs = (const float*)(ws + WS_CS) + (size_t)(row % SEQ) * 32 + 8 * (fq & 1); float r[8];
#pragma unroll
                        for (int j = 0; j < 8; ++j) { const float y = xget32(x[j], fq >= 2); const float c = cs[j], sn = cs[16 + j]; r[j] = (fq < 2) ? (x[j] * c - y * sn) : (x[j] * c + y * sn); }
                        u32x4 w; w.x = pk2(r[0], r[1]); w.y = pk2(r[2], r[3]); w.z = pk2(r[4], r[5]); w.w = pk2(r[6], r[7]);
                        bf16* kfp = (bf16*)(ws + WS_KF) + (size_t)row * 1024 + 64 + 8 * fq;
#pragma unroll
                        for (int hh = 0; hh < 8; ++hh) *(u32x4*)(kfp + hh * 128) = w; } }
        } else if (pn <= 4) {
            bf16* base = (bf16*)(ws + WS_U);
#pragma unroll
            for (int ai = 0; ai < 2; ++ai)
#pragma unroll
                for (int m = 0; m < 4; ++m) { bf16* rowp = base + (size_t)(row0 + ai * 128 + m * 16) * 256 + (pn - 3) * 128 + cl; float r[8]; const float sxr = I8 ? sc[wr * 64 + fr + ai * 128 + m * 16] : 1.f;
#pragma unroll
                    for (int n = 0; n < 2; ++n) { const f32x4 va = ZV(ai, 0, m, n), vg = ZV(ai, 1, m, n);
#pragma unroll
                        for (int k = 0; k < 4; ++k) r[n * 4 + k] = va[k] * sigmoidf_(vg[k]); }
                    u32x4 w; w.x = pk2(r[0], r[1]); w.y = pk2(r[2], r[3]); w.z = pk2(r[4], r[5]); w.w = pk2(r[6], r[7]);
                    *(u32x4*)rowp = w; }
        } else {
            bf16* base = (bf16*)(ws + WS_GS); f32x2* stp = (f32x2*)(ws + WS_STV);
#pragma unroll
            for (int ai = 0; ai < 2; ++ai)
#pragma unroll
                for (int m = 0; m < 4; ++m) { const int row = row0 + ai * 128 + m * 16; bf16* rowp = base + (size_t)row * 512 + (pn - 5) * 256 + cl; float s1 = 0.f, s2 = 0.f; const float sxr = I8 ? sc[row - u.pm * 256] : 1.f;
#pragma unroll
                    for (int bj = 0; bj < 2; ++bj) { const f32x4 v0 = ZV(ai, bj, m, 0), v1 = ZV(ai, bj, m, 1);
                        const f32x2 a = gelu_pk((f32x2){v0[0], v0[1]}), b = gelu_pk((f32x2){v0[2], v0[3]}), c = gelu_pk((f32x2){v1[0], v1[1]}), d = gelu_pk((f32x2){v1[2], v1[3]});
                        s1 += (a.x + a.y) + (b.x + b.y) + (c.x + c.y) + (d.x + d.y); s2 += (a.x * a.x + a.y * a.y) + (b.x * b.x + b.y * b.y) + (c.x * c.x + c.y * c.y) + (d.x * d.x + d.y * d.y);
                        u32x4 w; w.x = pk2(a.x, a.y); w.y = pk2(b.x, b.y); w.z = pk2(c.x, c.y); w.w = pk2(d.x, d.y);
                        *(u32x4*)(rowp + bj * 128) = w; }
                    if (pn == 6) { s1 = xsum16(s1); s1 = xsum32(s1); s2 = xsum16(s2); s2 = xsum32(s2); if (fq == 0) stp[(size_t)row * 4 + wc] = (f32x2){s1, s2}; } }
        }
#undef ZV
    }
};
struct EpiBfScale {
    static constexpr bool PERM = true;
    bf16* O; int ldc; const float* ssq; float inv_n;
    __device__ __forceinline__ void operator()(AccRef acc, const Unit& u, int wr, int wc, int fr, int fq) const {
        const int row0 = u.pm * 256 + wr * 64 + fr, col0 = u.pn * 256 + wc * 32 + 8 * fq;
#pragma unroll
        for (int ai = 0; ai < 2; ++ai)
#pragma unroll
            for (int m = 0; m < 4; ++m) { const int row = row0 + ai * 128 + m * 16; bf16* rowp = O + (size_t)row * ldc + col0;
                const f32x4 p = *(const f32x4*)(ssq + (size_t)row * 4); const float rs = 1.0f / sqrtf(((p[0] + p[1]) + (p[2] + p[3])) * inv_n + EPS);
#pragma unroll
                for (int bj = 0; bj < 2; ++bj) { const f32x4 v0 = acc[ai][bj][m][0] * rs, v1 = acc[ai][bj][m][1] * rs;
                    u32x4 w; w.x = pk2(v0[0], v0[1]); w.y = pk2(v0[2], v0[3]); w.z = pk2(v1[0], v1[1]); w.w = pk2(v1[2], v1[3]);
                    *(u32x4*)(rowp + bj * 128) = w; } }
    }
};
struct EpiQ {
    static constexpr bool PERM = true;
    bf16* O; const float* ssq; const float* CS;
    __device__ __forceinline__ void operator()(AccRef acc, const Unit& u, int wr, int wc, int fr, int fq) const {
        const int row0 = u.pm * 256 + wr * 64 + fr;
        const int cg0 = u.pn * 256 + wc * 32; const bool rope0 = (cg0 % 96) == 64, rope1 = ((cg0 + 128) % 96) == 64;
#pragma unroll
        for (int ai = 0; ai < 2; ++ai) {
          f32x4 pq[4], cq[4][4];
#pragma unroll
          for (int m = 0; m < 4; ++m) pq[m] = *(const f32x4*)(ssq + (size_t)(row0 + ai * 128 + m * 16) * 4);
          if (rope0 || rope1) {
#pragma unroll
            for (int m = 0; m < 4; ++m) { const float* cs = CS + (size_t)((row0 + ai * 128 + m * 16) % SEQ) * 32 + 8 * (fq & 1);
                cq[m][0] = *(const f32x4*)(cs); cq[m][1] = *(const f32x4*)(cs + 4); cq[m][2] = *(const f32x4*)(cs + 16); cq[m][3] = *(const f32x4*)(cs + 20); }
          } else {
#pragma unroll
            for (int m = 0; m < 4; ++m)
#pragma unroll
                for (int q = 0; q < 4; ++q) cq[m][q] = (f32x4){0.f, 0.f, 0.f, 0.f}; }
#pragma unroll
            for (int m = 0; m < 4; ++m) { const int row = row0 + ai * 128 + m * 16;
                const f32x4 p = pq[m]; const float rs = att2::C2 / sqrtf(((p[0] + p[1]) + (p[2] + p[3])) * (1.f / 256.f) + EPS);
                const float cs[32] = {cq[m][0][0], cq[m][0][1], cq[m][0][2], cq[m][0][3], cq[m][1][0], cq[m][1][1], cq[m][1][2], cq[m][1][3], 0.f, 0.f, 0.f, 0.f, 0.f, 0.f, 0.f, 0.f,
                                      cq[m][2][0], cq[m][2][1], cq[m][2][2], cq[m][2][3], cq[m][3][0], cq[m][3][1], cq[m][3][2], cq[m][3][3], 0.f, 0.f, 0.f, 0.f, 0.f, 0.f, 0.f, 0.f};
#pragma unroll
                for (int bj = 0; bj < 2; ++bj) { const int cg = u.pn * 256 + bj * 128 + wc * 32;
                    const f32x4 v0 = acc[ai][bj][m][0] * rs, v1 = acc[ai][bj][m][1] * rs; float x[8] = {v0[0], v0[1], v0[2], v0[3], v1[0], v1[1], v1[2], v1[3]};
                    if (bj == 0 ? rope0 : rope1) {
#pragma unroll
                        for (int j = 0; j < 8; ++j) { const float y = xget32(x[j], fq >= 2); const float c = cs[j], sn = cs[16 + j]; x[j] = (fq < 2) ? (x[j] * c - y * sn) : (x[j] * c + y * sn); } }
                    u32x4 w; w.x = pk2(x[0], x[1]); w.y = pk2(x[2], x[3]); w.z = pk2(x[4], x[5]); w.w = pk2(x[6], x[7]);
                    *(u32x4*)(O + (size_t)row * 768 + cg + 8 * fq) = w; } }
          asm volatile("" ::: "memory"); }
    }
};
struct EpiKV {
    static constexpr bool PERM = true;
    bf16* KF; bf16* VB; const float* ssq;
    __device__ __forceinline__ void operator()(AccRef acc, const Unit& u, int wr, int wc, int fr, int fq) const {
        const int row0 = u.pm * 256 + wr * 64 + fr;
        f32x4 pq[2][4];
#pragma unroll
        for (int ai = 0; ai < 2; ++ai)
#pragma unroll
            for (int m = 0; m < 4; ++m) pq[ai][m] = *(const f32x4*)(ssq + (size_t)(row0 + ai * 128 + m * 16) * 4);
#pragma unroll
        for (int ai = 0; ai < 2; ++ai)
#pragma unroll
            for (int m = 0; m < 4; ++m) { const int row = row0 + ai * 128 + m * 16;
                const f32x4 p = pq[ai][m]; const float rs = 1.0f / sqrtf(((p[0] + p[1]) + (p[2] + p[3])) * (1.f / 128.f) + EPS);
#pragma unroll
                for (int bj = 0; bj < 2; ++bj) { const int hd = 2 * u.pn + bj; const f32x4 v0 = acc[ai][bj][m][0] * rs, v1 = acc[ai][bj][m][1] * rs;
                    u32x4 w; w.x = pk2(v0[0], v0[1]); w.y = pk2(v0[2], v0[3]); w.z = pk2(v1[0], v1[1]); w.w = pk2(v1[2], v1[3]);
                    bf16* dst = (wc < 2) ? (KF + (size_t)row * 1024 + hd * 128 + wc * 32 + 8 * fq) : (VB + (size_t)row * 512 + hd * 64 + (wc - 2) * 32 + 8 * fq);
                    *(u32x4*)dst = w; } }
    }
};
struct EpiBf {
    static constexpr bool PERM = true;
    bf16* O; int ldc; int pm0;
    __device__ __forceinline__ void operator()(AccRef acc, const Unit& u, int wr, int wc, int fr, int fq) const {
        const int row0 = (u.pm - pm0) * 256 + wr * 64 + fr, col0 = u.pn * 256 + wc * 32 + 8 * fq;
#pragma unroll
        for (int ai = 0; ai < 2; ++ai)
#pragma unroll
            for (int m = 0; m < 4; ++m) { bf16* rowp = O + (size_t)(row0 + ai * 128 + m * 16) * ldc + col0;
#pragma unroll
                for (int bj = 0; bj < 2; ++bj) { const f32x4 v0 = acc[ai][bj][m][0], v1 = acc[ai][bj][m][1];
                    u32x4 w; w.x = pk2(v0[0], v0[1]); w.y = pk2(v0[2], v0[3]); w.z = pk2(v1[0], v1[1]); w.w = pk2(v1[2], v1[3]);
                    *(u32x4*)(rowp + bj * 128) = w; } }
    }
};
struct EpiMoeDown {
    static constexpr bool PERM = true;
    bf16* Y; float* YF;
    __device__ __forceinline__ void operator()(AccRef acc, const Unit& u, int wr, int wc, int fr_, int fq_) const {
        int ln_ = lane_id(); asm volatile("" : "+v"(ln_)); const int fr = ln_ & 15, fq = ln_ >> 4; (void)fr_; (void)fq_;
        const int row0 = u.pm * 256 + wr * 64 + fr, col0 = u.pn * 256 + wc * 32 + 8 * fq; constexpr float UNS = 1.0f / (F8_SH * F8_SW);
        if (u.aux == 0) {
#pragma unroll
            for (int ai = 0; ai < 2; ++ai)
#pragma unroll
                for (int m = 0; m < 4; ++m) { unsigned char* rowp = (unsigned char*)Y + (size_t)(row0 + ai * 128 + m * 16) * DM + col0;
#pragma unroll
                    for (int bj = 0; bj < 2; ++bj) { const f32x4 v0 = acc[ai][bj][m][0] * (UNS * F8_SY), v1 = acc[ai][bj][m][1] * (UNS * F8_SY);
                        *(v2u*)(rowp + bj * 128) = (v2u){f8x4(v0[0], v0[1], v0[2], v0[3]), f8x4(v1[0], v1[1], v1[2], v1[3])}; } }
        } else {
            float* slab = YF + (size_t)(u.aux - 1) * (8 * 256 * DM);
#pragma unroll
            for (int ai = 0; ai < 2; ++ai)
#pragma unroll
                for (int m = 0; m < 4; ++m) { float* rowp = slab + (size_t)(row0 - 32768 + ai * 128 + m * 16) * DM + col0;
#pragma unroll
                    for (int bj = 0; bj < 2; ++bj) { *(f32x4*)(rowp + bj * 128) = acc[ai][bj][m][0] * UNS; *(f32x4*)(rowp + bj * 128 + 4) = acc[ai][bj][m][1] * UNS; } }
        }
    }
};
template <bool I8, bool F8OUT = false, bool F8IN = false> struct EpiSwiGLUT {
    static constexpr bool PERM = true;
    bf16* H; int ldc; int pm0; const float* sx; const float* sw;
    __device__ __forceinline__ const float* pf_ptr(const Unit& u, int w) const { return w == 0 ? sx + u.pm * 256 : sw + (size_t)u.aux * 7168 + u.pn * 256; }
    __device__ __forceinline__ void operator()(AccRef acc, const Unit& u, int wr, int wc, int fr, int fq) const { body(acc, u, wr, wc, fr, fq, nullptr); }
    __device__ __forceinline__ void operator()(AccRef acc, const Unit& u, int wr, int wc, int fr, int fq, const LAS float* sc) const { body(acc, u, wr, wc, fr, fq, sc); }
    __device__ __forceinline__ void body(AccRef acc, const Unit& u, int wr, int wc, int fr, int fq, const LAS float* sc) const {
        const int row0 = (u.pm - pm0) * 256 + wr * 64 + fr, col0 = u.pn * 128 + wc * 32 + 8 * fq;
        f32x4 sg[2], su[2];
        if (I8) {
#pragma unroll
            for (int n = 0; n < 2; ++n) { sg[n] = *(const LAS f32x4*)(sc + 256 + wc * 32 + 8 * fq + 4 * n); su[n] = *(const LAS f32x4*)(sc + 256 + 128 + wc * 32 + 8 * fq + 4 * n); } }
#pragma unroll
        for (int ai = 0; ai < 2; ++ai)
#pragma unroll
            for (int m = 0; m < 4; ++m) { bf16* rowp = H + (size_t)(row0 + ai * 128 + m * 16) * ldc + col0;
                unsigned char* rowp8 = (unsigned char*)H + (size_t)(row0 + ai * 128 + m * 16) * ldc + col0; (void)rowp8; (void)rowp;
                float r[8]; const float sxr = I8 ? sc[wr * 64 + fr + ai * 128 + m * 16] : 1.f;
#pragma unroll
                for (int n = 0; n < 2; ++n)
#pragma unroll
                    for (int k = 0; k < 4; ++k) {
                        float gq, up;
                        if (I8) { gq = (float)__builtin_bit_cast(pg8::i32x4, acc[ai][0][m][n])[k] * (sxr * sg[n][k]); up = (float)__builtin_bit_cast(pg8::i32x4, acc[ai][1][m][n])[k] * (sxr * su[n][k]); }
                        else if (F8IN && F8OUT) { constexpr float C8 = 1.0f / (F8_SA * F8_SWU);
                            const float ag = acc[ai][0][m][n][k], au = acc[ai][1][m][n][k];
                            r[n * 4 + k] = (ag * au) * (C8 * C8 * F8_SH) * __builtin_amdgcn_rcpf(1.0f + __builtin_amdgcn_exp2f(ag * (-1.4426950408889634f * C8))); continue; }
                        else { constexpr float C8 = F8IN ? 1.0f / (F8_SA * F8_SWU) : 1.0f; gq = acc[ai][0][m][n][k] * C8; up = acc[ai][1][m][n][k] * C8; }
                        r[n * 4 + k] = gq * sigmoidf_(gq) * up; }
                if constexpr (F8OUT) { constexpr float SO = (F8IN && F8OUT) ? 1.0f : F8_SH;
                    *(v2u*)rowp8 = (v2u){f8x4(r[0] * SO, r[1] * SO, r[2] * SO, r[3] * SO), f8x4(r[4] * SO, r[5] * SO, r[6] * SO, r[7] * SO)}; }
                else { u32x4 w; w.x = pk2(r[0], r[1]); w.y = pk2(r[2], r[3]); w.z = pk2(r[4], r[5]); w.w = pk2(r[6], r[7]);
                *(u32x4*)rowp = w; } }
    }
};
typedef EpiSwiGLUT<false> EpiSwiGLU;
template <class TB> struct EpiResB {
    static constexpr bool PERM = true;
    const TB* base; bf16* out; float asc;
    __device__ __forceinline__ void operator()(AccRef acc, const Unit& u, int wr, int wc, int fr, int fq) const {
        const int row0 = u.pm * 256 + wr * 64 + fr, col0 = u.pn * 256 + wc * 32 + 8 * fq;
#pragma unroll
        for (int ai = 0; ai < 2; ++ai) {
            f32x4 b[4][2][2];
#pragma unroll
            for (int m = 0; m < 4; ++m)
#pragma unroll
                for (int bj = 0; bj < 2; ++bj) { const size_t off = (size_t)(row0 + ai * 128 + m * 16) * DM + col0 + bj * 128;
                    if constexpr (sizeof(TB) == 4) { b[m][bj][0] = *(const f32x4*)((const float*)base + off); b[m][bj][1] = *(const f32x4*)((const float*)base + off + 4); }
                    else { const u32x4 z = *(const u32x4*)((const bf16*)base + off); b[m][bj][0] = __builtin_bit_cast(f32x4, z); } }
#pragma unroll
            for (int m = 0; m < 4; ++m)
#pragma unroll
                for (int bj = 0; bj < 2; ++bj) { const size_t off = (size_t)(row0 + ai * 128 + m * 16) * DM + col0 + bj * 128; f32x4 v0, v1;
                    if constexpr (sizeof(TB) == 4) { v0 = b[m][bj][0]; v1 = b[m][bj][1]; }
                    else { const u32x4 z = __builtin_bit_cast(u32x4, b[m][bj][0]); v0 = (f32x4){bflo(z.x), bfhi(z.x), bflo(z.y), bfhi(z.y)}; v1 = (f32x4){bflo(z.z), bfhi(z.z), bflo(z.w), bfhi(z.w)}; }
                    v0 += acc[ai][bj][m][0] * asc; v1 += acc[ai][bj][m][1] * asc;
                    u32x4 w; w.x = pk2(v0[0], v0[1]); w.y = pk2(v0[2], v0[3]); w.z = pk2(v1[0], v1[1]); w.w = pk2(v1[2], v1[3]);
                    *(u32x4*)(out + off) = w; }
            asm volatile("" ::: "memory"); }
    }
};
__device__ __forceinline__ u32x4 ld16_sc1(const void* p) { const unsigned long long a = __hip_atomic_load((const unsigned long long*)p, __ATOMIC_RELAXED, __HIP_MEMORY_SCOPE_AGENT), b = __hip_atomic_load((const unsigned long long*)p + 1, __ATOMIC_RELAXED, __HIP_MEMORY_SCOPE_AGENT); return (u32x4){(unsigned)a, (unsigned)(a >> 32), (unsigned)b, (unsigned)(b >> 32)}; }
struct EpiGate {
    static constexpr bool PERM = true;
    bf16* TG; const float* bg; bf16* MG; const float* sx; const float* sw;
    __device__ static __forceinline__ bool unit_i8(const Unit& u) { return GATE_I8 && (u.aux & 1) == 0; }
    __device__ __forceinline__ const float* pf_ptr(const Unit& u, int w) const { if (u.aux & 1) return nullptr; return w == 0 ? sx + u.pm * 256 : sw + (u.aux >> 1) * 1024 + u.pn * 256; }
    __device__ __forceinline__ void operator()(AccRef acc, const Unit& u, int wr, int wc, int fr_, int fq_, const LAS float* sc, unsigned (&tg)[32]) const {
        int ln_ = lane_id(); asm volatile("" : "+v"(ln_)); const int fr = ln_ & 15, fq = ln_ >> 4; (void)fr_; (void)fq_;
        const int br = u.aux >> 1, kind = u.aux & 1; const int lr0 = wr * 64 + fr, lc0 = wc * 32 + 8 * fq;
        if (kind == 0) {
            constexpr float NL2E = -1.4426950408889634f, I255 = 1.f / 255.f;
            f32x4 bb[2][2];
#pragma unroll
            for (int bj = 0; bj < 2; ++bj)
#pragma unroll
                for (int n = 0; n < 2; ++n) bb[bj][n] = *(const f32x4*)(bg + br * 1024 + u.pn * 256 + lc0 + bj * 128 + 4 * n);
#pragma unroll
            for (int bj = 0; bj < 2; ++bj)
#pragma unroll
                for (int n = 0; n < 2; ++n) {
                    const f32x4 b0 = bb[bj][n] * NL2E, w0 = *(const LAS f32x4*)(sc + 256 + lc0 + bj * 128 + 4 * n) * NL2E;
#pragma unroll
                    for (int ai = 0; ai < 2; ++ai)
#pragma unroll
                        for (int m = 0; m < 4; ++m) { const int lr = lr0 + ai * 128 + m * 16; const float sxr = sc[lr];
                            const pg8::i32x4 a0 = __builtin_bit_cast(pg8::i32x4, acc[ai][bj][m][n]); unsigned q = 0u;
#pragma unroll
                            for (int k = 0; k < 4; ++k) { const float zz = GATE_I8 ? __builtin_fmaf((float)a0[k], sxr * w0[k], b0[k]) : __builtin_fmaf(acc[ai][bj][m][n][k], NL2E, b0[k]);
                                const float r = __builtin_amdgcn_rcpf(__builtin_fmaf(__builtin_amdgcn_exp2f(zz), I255, I255));
                                q = __builtin_amdgcn_cvt_pk_u8_f32(__builtin_rintf(r), k, q); }
                            tg[((ai * 2 + bj) * 4 + m) * 2 + n] = q; } }
        } else {
#pragma unroll
            for (int ai = 0; ai < 2; ++ai) {
                u32x4 pp[4][2];
                if (br > 0) {
#pragma unroll
                    for (int m = 0; m < 4; ++m) { const int lr = lr0 + ai * 128 + m * 16; const bf16* mp = MG + (size_t)(u.pm * 256 + lr) * DM + u.pn * 256 + lc0;
#pragma unroll
                        for (int bj = 0; bj < 2; ++bj) pp[m][bj] = *(const u32x4*)(mp + bj * 128); }
                } else {
#pragma unroll
                    for (int m = 0; m < 4; ++m)
#pragma unroll
                        for (int bj = 0; bj < 2; ++bj) pp[m][bj] = (u32x4){0u, 0u, 0u, 0u}; }
#pragma unroll
                for (int m = 0; m < 4; ++m) { const int lr = lr0 + ai * 128 + m * 16; bf16* mp = MG + (size_t)(u.pm * 256 + lr) * DM + u.pn * 256 + lc0;
#pragma unroll
                    for (int bj = 0; bj < 2; ++bj) {
                        const unsigned z0 = tg[((ai * 2 + bj) * 4 + m) * 2 + 0], z1 = tg[((ai * 2 + bj) * 4 + m) * 2 + 1]; constexpr float I255 = 1.f / 255.f;
                        float gt[8] = {(float)(z0 & 0xffu) * I255, (float)((z0 >> 8) & 0xffu) * I255, (float)((z0 >> 16) & 0xffu) * I255, (float)(z0 >> 24) * I255,
                                       (float)(z1 & 0xffu) * I255, (float)((z1 >> 8) & 0xffu) * I255, (float)((z1 >> 16) & 0xffu) * I255, (float)(z1 >> 24) * I255}; float r[8];
#pragma unroll
                        for (int n = 0; n < 2; ++n)
#pragma unroll
                            for (int k = 0; k < 4; ++k) r[n * 4 + k] = gt[n * 4 + k]
                                * acc[ai][bj][m][n][k]
                                ;
                        { const u32x4 p = pp[m][bj];
                            r[0] += bflo(p.x); r[1] += bfhi(p.x); r[2] += bflo(p.y); r[3] += bfhi(p.y); r[4] += bflo(p.z); r[5] += bfhi(p.z); r[6] += bflo(p.w); r[7] += bfhi(p.w); }
                        u32x4 w; w.x = pk2(r[0], r[1]); w.y = pk2(r[2], r[3]); w.z = pk2(r[4], r[5]); w.w = pk2(r[6], r[7]);
                        *(u32x4*)(mp + bj * 128) = w; } }
                asm volatile("" ::: "memory"); }
        }
    }
};

struct Frame {
    LAS unsigned char* lds; volatile LAS unsigned* MISC; gu32* ctl;
    int wave, G, gw, NGW;
    unsigned char* ws;
};
struct Args { const float* in[33]; float* out; unsigned char* ws; int ph_lo, ph_hi, li, pad; };

__device__ __forceinline__ void tr_item(const float* W, int srcld, int n_begin, int nblk, bf16* WT, int dstld, int drow0, int dcol0, int blk, int blkstride, const float* ks,
                                        LAS float* scr, int item, int lane) {
    const int kb = item / nblk, nb = item % nblk, k0 = 64 * kb, n0l = 32 * nb, n0 = n_begin + n0l;
    const int drow = drow0 + (n0l / blk) * blkstride + (n0l % blk);
    float wv_[32];
#pragma unroll
    for (int i = 0; i < 32; ++i) { const int kk = 2 * i + (lane >> 5); wv_[i] = __builtin_nontemporal_load(&W[(size_t)(k0 + kk) * srcld + n0 + (lane & 31)]); }
#pragma unroll
    for (int i = 0; i < 32; ++i) { const int kk = 2 * i + (lane >> 5); const float sc = ks ? ks[k0 + kk] : 1.0f; scr[kk * 33 + (lane & 31)] = wv_[i] * sc; }
    LDS_WAIT(); asm volatile("" ::: "memory");
    const int c = lane & 7;
#pragma unroll
    for (int j = 0; j < 4; ++j) { const int n = (lane >> 3) + 8 * j; const LAS float* s = scr + (8 * c) * 33 + n;
        v4u o; o.x = pk2(s[0 * 33], s[1 * 33]); o.y = pk2(s[2 * 33], s[3 * 33]); o.z = pk2(s[4 * 33], s[5 * 33]); o.w = pk2(s[6 * 33], s[7 * 33]);
        *(GAS v4u*)(WT + (size_t)(drow + n) * dstld + dcol0 + k0 + 8 * c) = o; }
    LDS_WAIT(); asm volatile("" ::: "memory");
}
__device__ __forceinline__ void tr_item_f8(const float* W, int srcld, int nblk, unsigned char* WT8, int dstld, LAS float* scr, int item, int lane) {
    const int kb = item / nblk, nb = item % nblk, k0 = 64 * kb, n0 = 32 * nb;
    float wv_[32];
#pragma unroll
    for (int i = 0; i < 32; ++i) { const int kk = 2 * i + (lane >> 5); wv_[i] = __builtin_nontemporal_load(&W[(size_t)(k0 + kk) * srcld + n0 + (lane & 31)]); }
#pragma unroll
    for (int i = 0; i < 32; ++i) { const int kk = 2 * i + (lane >> 5); scr[kk * 33 + (lane & 31)] = wv_[i] * F8_SW; }
    LDS_WAIT(); asm volatile("" ::: "memory");
    const int c = lane & 7;
#pragma unroll
    for (int j = 0; j < 4; ++j) { const int n = (lane >> 3) + 8 * j; const LAS float* s = scr + (8 * c) * 33 + n;
        *(GAS v2u*)(WT8 + (size_t)(n0 + n) * dstld + k0 + 8 * c) = (v2u){f8x4(s[0 * 33], s[1 * 33], s[2 * 33], s[3 * 33]), f8x4(s[4 * 33], s[5 * 33], s[6 * 33], s[7 * 33])}; }
    LDS_WAIT(); asm volatile("" ::: "memory");
}
__device__ __forceinline__ void poolfold_item(const float* w_in, const float* wp, const float* psc, bf16* WT, LAS float* scr, int item, int lane) {
    const int kb = item >> 2, g = item & 3, k0 = 16 * kb;
#pragma unroll
    for (int k = 0; k < 16; ++k) scr[k * 64 + lane] = w_in[(size_t)(k0 + k) * D_IN + g * 64 + lane];
    float wc[64];
#pragma unroll
    for (int c = 0; c < 64; ++c) wc[c] = wp[(size_t)(g * 64 + c) * 64 + lane];
    const float sc = psc[g * 64 + lane];
    LDS_WAIT(); asm volatile("" ::: "memory");
    bf16* orow = WT + (size_t)(g * 64 + lane) * XLD + k0;
#pragma unroll 1
    for (int k8 = 0; k8 < 2; ++k8) { float r[8];
#pragma unroll
        for (int kk = 0; kk < 8; ++kk) { float a = 0.f; const LAS float* sp = scr + (k8 * 8 + kk) * 64;
#pragma unroll
            for (int c = 0; c < 64; ++c) a += sp[c] * wc[c];
            r[kk] = a * sc; }
        *(GAS v4u*)(orow + k8 * 8) = (v4u){pk2(r[0], r[1]), pk2(r[2], r[3]), pk2(r[4], r[5]), pk2(r[6], r[7])}; }
    LDS_WAIT(); asm volatile("" ::: "memory");
}
__device__ const double ROPE_INV[16] = {1.0, 0.5623413251903491, 0.31622776601683794, 0.1778279410038923, 0.1, 0.05623413251903491, 0.03162277660168379, 0.01778279410038923,
                                        0.01, 0.005623413251903491, 0.0031622776601683794, 0.0017782794100389228, 0.001, 0.0005623413251903491, 0.00031622776601683794, 0.00017782794100389227};

__device__ __forceinline__ void panel_load(const float* W, int n0, int w, int lane, float (&wv)[64]) {
    const float* p = W + (size_t)(w * 128 + (lane >> 5)) * DFFE + n0 + (lane & 31);
#pragma unroll
    for (int i = 0; i < 64; ++i) wv[i] = __builtin_nontemporal_load(p + (size_t)(2 * i) * DFFE);
}
__device__ __forceinline__ void p_moe_panels(Frame& F, const Args& a) {
    constexpr int NIT = NEXP * 2 * (DFFE / 32);
    const int lane = lane_id(), w = F.wave, G = F.G;
    LAS float* scr = (LAS float*)F.lds; LAS float* cmax = (LAS float*)(F.lds + SC_LDS_OFF);
    unsigned char* ws = F.ws;
    float wv[64];
    int item = (int)blockIdx.x;
#define PANEL_SRC(it_) (a.in[29 + (((it_) % 224) / 112)] + (size_t)((it_) / 224) * DM * DFFE)
    if (item < NIT) panel_load(PANEL_SRC(item), 32 * (item % 112), w, lane, wv);
    for (; item < NIT; item += G) {
        const int e = item / 224, isup = (item % 224) / 112, nb = item % 112;
        float am = 0.f;
#if !MOE_UP_F8
#pragma unroll
        for (int i = 0; i < 64; ++i) am = fmaxf(am, fabsf(wv[i]));
        am = fmaxf(am, __shfl_xor(am, 32));
#endif
#pragma unroll
        for (int i = 0; i < 64; ++i) { const int k = w * 128 + 2 * i + (lane >> 5); scr[k * 32 + (((lane & 31) + (k >> 4)) & 31)] = wv[i]; }
        if (lane < 32) cmax[w * 32 + lane] = am;
        asm volatile("s_waitcnt lgkmcnt(0)\n\ts_barrier" ::: "memory");
        const int nxt = item + G;
        if (nxt < NIT) panel_load(PANEL_SRC(nxt), 32 * (nxt % 112), w, lane, wv);
        const int drow0 = isup * 128 + (nb >> 2) * 256 + (nb & 3) * 32;
        unsigned char* dst = ws + WS_MGU + (size_t)e * SZ_MGU8; float* swp = (float*)(ws + WS_SWMOE) + e * (2 * DFFE);
#pragma unroll
        for (int i = 0; i < 4; ++i) { const int n = 4 * w + i;
            float amn = cmax[n];
#pragma unroll
            for (int ww = 1; ww < 8; ++ww) amn = fmaxf(amn, cmax[ww * 32 + n]);
            const float sc = amn > 0.f ? amn * (1.f / 127.f) : 1.f, inv = amn > 0.f ? 127.f / amn : 0.f;
            const LAS float* sp = scr + (16 * lane) * 32 + ((n + lane) & 31);
            float x[16];
#pragma unroll
            for (int j = 0; j < 16; ++j) x[j] = sp[j * 32];
#if MOE_UP_F8
            const v4u q = (v4u){f8x4(x[0] * F8_SWU, x[1] * F8_SWU, x[2] * F8_SWU, x[3] * F8_SWU), f8x4(x[4] * F8_SWU, x[5] * F8_SWU, x[6] * F8_SWU, x[7] * F8_SWU), f8x4(x[8] * F8_SWU, x[9] * F8_SWU, x[10] * F8_SWU, x[11] * F8_SWU), f8x4(x[12] * F8_SWU, x[13] * F8_SWU, x[14] * F8_SWU, x[15] * F8_SWU)}; (void)inv;
#else
            const v4u q = (v4u){q8x4(x[0], x[1], x[2], x[3], inv), q8x4(x[4], x[5], x[6], x[7], inv), q8x4(x[8], x[9], x[10], x[11], inv), q8x4(x[12], x[13], x[14], x[15], inv)};
#endif
            *(v4u*)(dst + (size_t)(drow0 + n) * DM + 16 * lane) = q; if (lane == 0) swp[drow0 + n] = sc; }
        asm volatile("s_waitcnt lgkmcnt(0)\n\ts_barrier" ::: "memory");
    }
#undef PANEL_SRC
}
__device__ __forceinline__ void p_prologue(Frame& F, const Args& a) {
    const int lane_v = lane_id(), tid_v = F.wave * 64 + lane_v; (void)tid_v;
    LAS float* scr = (LAS float*)(F.lds + F.wave * 16384);
    unsigned char* ws = F.ws;
    p_moe_panels(F, a);
    int it = F.gw;
    const int NGW = F.NGW;
#define JOB(src, K_, srcld, nbeg, ncnt, dst, dstld, drow0, dcol0, blk, blkstride, ks) do { const int nblk_ = (ncnt) / 32, nit_ = ((K_) / 64) * nblk_; \
        for (; it < nit_; it += NGW) tr_item((src), (srcld), (nbeg), nblk_, (dst), (dstld), (drow0), (dcol0), (blk), (blkstride), (ks), scr, it, lane_v); it -= nit_; } while (0)
    for (int l = 0; l < 2; ++l) {
        const float* w_in = a.in[2] + (size_t)l * DM * D_IN; bf16* win_t = (bf16*)(ws + WS_WIN + l * SZ_WIN);
        { const int nit_ = 64 * 4; for (; it < nit_; it += NGW) poolfold_item(w_in, a.in[4] + (size_t)l * 4 * 64 * 64, a.in[5] + l * 256, win_t, scr, it, lane_v); it -= nit_; }
        JOB(w_in, DM, D_IN, 256, 416, win_t, XLD, 256, 0, 416, 0, nullptr);
        JOB(w_in, DM, D_IN, 672, 256, win_t, XLD, 768, 0, 128, 256, nullptr);
        JOB(w_in, DM, D_IN, 928, 256, win_t, XLD, 896, 0, 128, 256, nullptr);
        JOB(w_in, DM, D_IN, 1184, 4608, win_t, XLD, 1280, 0, 4608, 0, nullptr);
        bf16* wcat = (bf16*)(ws + WS_WCAT + l * SZ_WCAT);
        JOB(a.in[6] + (size_t)l * 256 * DM, 256, DM, 0, DM, wcat, KCAT, 0, F_POOL, DM, 0, nullptr);
        JOB(a.in[11] + (size_t)l * 512 * DM, 512, DM, 0, DM, wcat, KCAT, 0, F_MLA, DM, 0, nullptr);
        JOB(a.in[16] + (size_t)l * 256 * DM, 256, DM, 0, DM, wcat, KCAT, 0, F_CONV, DM, 0, nullptr);
        JOB(a.in[21] + (size_t)l * 256 * DM, 256, DM, 0, DM, wcat, KCAT, 0, F_SGU, DM, 0, nullptr);
        JOB(a.in[22] + (size_t)l * DM * DM, DM, DM, 0, DM, (bf16*)(ws + WS_WO + l * SZ_WO), DM, 0, 0, DM, 0, nullptr);
        JOB(a.in[8] + (size_t)l * 256 * 768, 256, 768, 0, 768, (bf16*)(ws + WS_WUQ + l * SZ_WUQ), 256, 0, 0, 768, 0, a.in[7] + l * 256);
        JOB(a.in[10] + (size_t)l * 128 * 1024, 128, 1024, 0, 1024, (bf16*)(ws + WS_WUKV + l * SZ_WUKV), 256, 0, 0, 1024, 0, a.in[9] + l * 128);
    }
    JOB(a.in[24], DM, DFF, 0, DFF, (bf16*)(ws + WS_WGU0), DM, 0, 0, 128, 256, nullptr);
    JOB(a.in[25], DM, DFF, 0, DFF, (bf16*)(ws + WS_WGU0), DM, 128, 0, 128, 256, nullptr);
    { const int nblk_ = DM / 32, nit_ = (DFF / 64) * nblk_;
      for (; it < nit_; it += NGW) tr_item_f8(a.in[26], DM, nblk_, ws + WS_WD0, DFF, scr, it, lane_v); it -= nit_; }
#ifndef PROBE_PRO
#define PROBE_PRO 0
#endif
    for (int rp_ = 0; rp_ < 1 + PROBE_PRO; ++rp_)
    for (int e = 0; e < NEXP; ++e) {
        { const int nblk_ = DM / 32, nit_ = (DFFE / 64) * nblk_;
          for (; it < nit_; it += NGW) tr_item_f8(a.in[31] + (size_t)e * DFFE * DM, DM, nblk_, ws + WS_MD + (size_t)e * (SZ_MD / 2), DFFE, scr, it, lane_v); it -= nit_; }
    }
#undef JOB
    const int gt = F.gw * 64 + lane_v, NT = NGW * 64;
    for (int i = gt; i < 2 * 96 * (DM / 8); i += NT) { const int l = i / (96 * 128), r = (i / 128) % 96, c = i % 128;
        *(GAS v4u*)((bf16*)(ws + WS_WIN + l * SZ_WIN) + (size_t)(672 + r) * XLD + c * 8) = (v4u){0u, 0u, 0u, 0u}; }
    for (int i = gt; i < 2 * 1024 * 16; i += NT) { const int l = i / (1024 * 16), r = (i / 16) % 1024, c = i % 16;
        *(GAS v4u*)((bf16*)(ws + WS_WUKV + l * SZ_WUKV) + (size_t)r * 256 + 128 + c * 8) = (v4u){0u, 0u, 0u, 0u}; }
    float* cs = (float*)(ws + WS_CS);
    for (int i = gt; i < SEQ * 16; i += NT) { const int pos = i >> 4, k = i & 15; const double ang = (double)pos * ROPE_INV[k];
        double sn_, cn_; sincos(ang, &sn_, &cn_); cs[pos * 32 + k] = (float)cn_; cs[pos * 32 + 16 + k] = (float)sn_; }
}

template <bool ROUTER, bool Q8 = false, bool XB = false>
__device__ __forceinline__ void p_norm(Frame& F, const float* xin, const float* g, bf16* XN, const float* w_router, const float* b_router, float* SX = nullptr) {
    const int lane_v = lane_id(), tid_v = F.wave * 64 + lane_v; (void)tid_v;
    int lane_ = lane_v; asm volatile("" : "+v"(lane_));
    const GAS f32x4* gp = (const GAS f32x4*)g + lane_;
    f32x4 gv[4];
#pragma unroll
    for (int j = 0; j < 4; ++j) gv[j] = gp[64 * j];
    LAS int* lcnt = (LAS int*)(F.lds);
    int* tok_e = (int*)(F.ws + WS_TOK); int* tok_p = tok_e + 2 * M; float* tok_w = (float*)(tok_p + 2 * M);
    if (ROUTER) { if (tid_v < 16) lcnt[tid_v] = 0; __syncthreads(); }
    constexpr int NRF = ROUTER ? 2 : 4;
    for (int m0 = F.gw; m0 < M; m0 += NRF * F.NGW) {
      f32x4 vv[NRF][4];
#pragma unroll
      for (int r = 0; r < NRF; ++r) { const int mr = m0 + r * F.NGW;
        if constexpr (XB) { const GAS v2u* xr = (const GAS v2u*)((const bf16*)xin + (size_t)(mr < M ? mr : m0) * DM) + lane_v;
#pragma unroll
            for (int j = 0; j < 4; ++j) { const v2u z = xr[64 * j]; vv[r][j] = (f32x4){bflo(z.x), bfhi(z.x), bflo(z.y), bfhi(z.y)}; } }
        else { const GAS f32x4* xr = (const GAS f32x4*)(xin + (size_t)(mr < M ? mr : m0) * DM) + lane_v;
#pragma unroll
            for (int j = 0; j < 4; ++j) vv[r][j] = xr[64 * j]; } }
#pragma unroll
      for (int r = 0; r < NRF; ++r) { const int m = m0 + r * F.NGW; if (m < M) {
        f32x4 v[4]; float s = 0.f;
#pragma unroll
        for (int j = 0; j < 4; ++j) { v[j] = vv[r][j]; s += (v[j].x * v[j].x + v[j].y * v[j].y) + (v[j].z * v[j].z + v[j].w * v[j].w); }
        const float rs = 1.0f / sqrtf(wave_sum(s) * (1.f / DM) + EPS);
#pragma unroll
        for (int j = 0; j < 4; ++j) v[j] = v[j] * rs * gv[j];
        if (Q8 && ROUTER && MOE_UP_F8) {
            GAS unsigned* o4 = (GAS unsigned*)((unsigned char*)XN + (size_t)m * XLD * 2) + lane_v;
#pragma unroll
            for (int j = 0; j < 4; ++j) o4[64 * j] = f8x4(v[j].x * F8_SA, v[j].y * F8_SA, v[j].z * F8_SA, v[j].w * F8_SA);
        } else if (Q8) {
            float am = 0.f;
#pragma unroll
            for (int j = 0; j < 4; ++j) am = fmaxf(fmaxf(am, fmaxf(fabsf(v[j].x), fabsf(v[j].y))), fmaxf(fabsf(v[j].z), fabsf(v[j].w)));
            am = wave_max(am); const float inv = am > 0.f ? 127.f / am : 0.f;
            GAS unsigned* o4 = (GAS unsigned*)((unsigned char*)XN + (size_t)m * XLD * 2) + lane_v;
#pragma unroll
            for (int j = 0; j < 4; ++j) o4[64 * j] = (ROUTER && MOE_UP_F8) ? f8x4(v[j].x * F8_SA, v[j].y * F8_SA, v[j].z * F8_SA, v[j].w * F8_SA) : q8x4(v[j].x, v[j].y, v[j].z, v[j].w, inv);
            if (lane_v == 0) SX[m] = am > 0.f ? am * (1.f / 127.f) : 1.f;
        } else {
        GAS v2u* o8 = (GAS v2u*)(XN + (size_t)m * XLD) + lane_v;
#pragma unroll
        for (int j = 0; j < 4; ++j) o8[64 * j] = (v2u){pk2(v[j].x, v[j].y), pk2(v[j].z, v[j].w)};
        }
        if (ROUTER) {
            float lg[8];
#pragma unroll
            for (int e = 0; e < 8; ++e) lg[e] = 0.f;
#pragma unroll
            for (int j = 0; j < 4; ++j)
#pragma unroll
                for (int k = 0; k < 4; ++k) { const int col = 4 * lane_v + 256 * j + k; const f32x4 w0 = *(const f32x4*)(w_router + (size_t)col * 8), w1 = *(const f32x4*)(w_router + (size_t)col * 8 + 4);
                    const float hv = v[j][k];
                    lg[0] += hv * w0.x; lg[1] += hv * w0.y; lg[2] += hv * w0.z; lg[3] += hv * w0.w; lg[4] += hv * w1.x; lg[5] += hv * w1.y; lg[6] += hv * w1.z; lg[7] += hv * w1.w; }
#pragma unroll
            for (int e = 0; e < 8; ++e) lg[e] = wave_sum(lg[e]) + b_router[e];
            int e0 = 0; float v0 = lg[0];
#pragma unroll
            for (int e = 1; e < 8; ++e) if (lg[e] > v0) { v0 = lg[e]; e0 = e; }
            int e1 = -1; float v1 = -3.0e38f;
#pragma unroll
            for (int e = 0; e < 8; ++e) if (e != e0 && lg[e] > v1) { v1 = lg[e]; e1 = e; }
            const float ex = expf(v1 - v0), w0 = 1.0f / (1.0f + ex), w1 = ex / (1.0f + ex);
            if (lane_v == 0) { const int p0 = __hip_atomic_fetch_add(lcnt + e0, 1, __ATOMIC_RELAXED, __HIP_MEMORY_SCOPE_WORKGROUP), p1 = __hip_atomic_fetch_add(lcnt + e1, 1, __ATOMIC_RELAXED, __HIP_MEMORY_SCOPE_WORKGROUP);
                tok_e[2 * m] = e0; tok_e[2 * m + 1] = e1; tok_p[2 * m] = p0; tok_p[2 * m + 1] = p1; tok_w[2 * m] = w0; tok_w[2 * m + 1] = w1; }
        }
      } }
    }
    if (ROUTER) {
        VM_WAIT(); __syncthreads();
        if (tid_v < 8) lcnt[8 + tid_v] = (int)__hip_atomic_fetch_add((unsigned*)(F.ctl + CW_MOE + 64 * tid_v), (unsigned)lcnt[tid_v], RLX_AGENT);
        __syncthreads();
        { int* tix = (int*)(F.ws + WS_TIX);
            for (int m = F.gw + lane_v * F.NGW; m < M; m += 64 * F.NGW) { const int e0 = tok_e[2 * m], e1 = tok_e[2 * m + 1]; const int q0 = tok_p[2 * m] + lcnt[8 + e0], q1 = tok_p[2 * m + 1] + lcnt[8 + e1];
                tok_p[2 * m] = q0; tok_p[2 * m + 1] = q1; tix[(size_t)e0 * M + q0] = m; tix[(size_t)e1 * M + q1] = m; } }
        __syncthreads();
    }
}

__device__ __forceinline__ void p_thin(Frame& F, const Args& a, int l) {
    const int lane_v = lane_id(), tid_v = F.wave * 64 + lane_v; (void)tid_v;
    unsigned char* ws = F.ws;
    const bf16* ZP = (const bf16*)(ws + WS_ZP); const bf16* U = (const bf16*)(ws + WS_U); const bf16* GS = (const bf16*)(ws + WS_GS);
    bf16* Fb = (bf16*)(ws + WS_F);
    const int tid = tid_v, lane = lane_v, wave = F.wave;
    {
        const int gt = F.gw * 64 + lane, NT = F.NGW * 64;
        for (int task0 = gt; task0 < M * 32; task0 += 2 * NT) {
            v4u vw[2][16]; int cntv[2];
#pragma unroll
            for (int q = 0; q < 2; ++q) { const int tq = task0 + q * NT, task = tq < M * 32 ? tq : task0; const int m = task >> 5, ch = task & 31, pos = m % SEQ, w = 2 << (ch >> 3); const int cnt = (pos + 1 < w) ? pos + 1 : w; cntv[q] = cnt;
#pragma unroll
                for (int j = 0; j < 16; ++j) vw[q][j] = *(const v4u*)(ZP + (size_t)(m - (j < cnt ? j : 0)) * 256 + ch * 8); }
#pragma unroll
            for (int q = 0; q < 2; ++q) { const int task = task0 + q * NT; if (task < M * 32) { const int m = task >> 5, ch = task & 31, cnt = cntv[q];
                float s[8], c0[8];
#pragma unroll
                for (int k = 0; k < 8; ++k) s[k] = 0.f;
#pragma unroll
                for (int j = 0; j < 16; ++j) { const v4u v = vw[q][j]; const float f = (j < cnt) ? 1.f : 0.f;
                    const float x[8] = {bflo(v.x), bfhi(v.x), bflo(v.y), bfhi(v.y), bflo(v.z), bfhi(v.z), bflo(v.w), bfhi(v.w)};
#pragma unroll
                    for (int k = 0; k < 8; ++k) { s[k] += x[k] * f; if (j == 0) c0[k] = x[k]; } }
                const float inv = 1.0f / (float)cnt; float r[8];
#pragma unroll
                for (int k = 0; k < 8; ++k) r[k] = s[k] * inv - c0[k];
                *(v4u*)(Fb + (size_t)m * KCAT + F_POOL + ch * 8) = (v4u){pk2(r[0], r[1]), pk2(r[2], r[3]), pk2(r[4], r[5]), pk2(r[6], r[7])}; } } }
    }
    {
        LAS float* cwL = (LAS float*)F.lds;
        const float* cw = a.in[12] + (size_t)l * 31 * 256;
        for (int i = tid; i < 31 * 256; i += 512) cwL[i] = cw[i];
        const f32x4 cbv = *(const f32x4*)(a.in[13] + l * 256 + 4 * lane), lgv = *(const f32x4*)(a.in[14] + l * 256 + 4 * lane), lbv = *(const f32x4*)(a.in[15] + l * 256 + 4 * lane);
        __syncthreads();
        for (int grp = F.gw; grp < M / 8; grp += F.NGW) { const int t0 = grp * 8, pos0 = t0 % SEQ;
            v2u rw[38];
#pragma unroll
            for (int r = 0; r < 38; ++r) { rw[r] = (v2u){0u, 0u}; if (pos0 - 30 + r >= 0) rw[r] = *(const v2u*)(U + (size_t)(t0 - 30 + r) * 256 + 4 * lane); }
            f32x4 y[8];
#pragma unroll
            for (int tt = 0; tt < 8; ++tt) y[tt] = cbv;
#pragma unroll
            for (int r = 0; r < 38; ++r) { const f32x4 u = (f32x4){bflo(rw[r].x), bfhi(rw[r].x), bflo(rw[r].y), bfhi(rw[r].y)};
#pragma unroll
                for (int tt = 0; tt < 8; ++tt) { const int k = r - tt; if (k >= 0 && k <= 30) { const f32x4 wk = *(const LAS f32x4*)(cwL + k * 256 + 4 * lane); y[tt] += wk * u; } } }
#pragma unroll
            for (int tt = 0; tt < 8; ++tt) { const f32x4 v = y[tt];
                const float mean = wave_sum((v.x + v.y) + (v.z + v.w)) * (1.f / 256.f); const f32x4 dlt = v - mean;
                const float var = wave_sum((dlt.x * dlt.x + dlt.y * dlt.y) + (dlt.z * dlt.z + dlt.w * dlt.w)) * (1.f / 256.f); const float rstd = 1.0f / sqrtf(var + EPS);
                f32x4 o = dlt * rstd * lgv + lbv; o.x = o.x * sigmoidf_(o.x); o.y = o.y * sigmoidf_(o.y); o.z = o.z * sigmoidf_(o.z); o.w = o.w * sigmoidf_(o.w);
                *(v2u*)(Fb + (size_t)(t0 + tt) * KCAT + F_CONV + 4 * lane) = (v2u){pk2(o.x, o.y), pk2(o.z, o.w)}; } }
        __syncthreads();
    }
    {
        typedef short bf16x8_t __attribute__((ext_vector_type(8)));
        constexpr int WLD = 136;
        LAS bf16* Wb = (LAS bf16*)F.lds;
        LAS bf16* VT = (LAS bf16*)(F.lds + 128 * WLD * 2);
        LAS f32x2* ST = (LAS f32x2*)(F.lds + 128 * WLD * 2 + 64 * WLD * 2);
        const float* sw = a.in[19] + (size_t)l * 4 * 128 * 128; const float* sb = a.in[20] + l * 4 * 128; const float* lg = a.in[17] + l * 256; const float* lb = a.in[18] + l * 256;
        const f32x2* STV = (const f32x2*)(ws + WS_STV);
        int gprev = -1;
        for (int it = blockIdx.x; it < (M / 128) * 4; it += F.G) {
            const int nb = it >> 2, g = it & 3, m0 = nb * 128;
            const bool newg = (g != gprev); gprev = g;
            f32x4 wv[8];
            if (newg) {
#pragma unroll
            for (int i = 0; i < 8; ++i) wv[i] = *(const f32x4*)(sw + (size_t)g * 16384 + (size_t)(tid + 512 * i) * 4); }
            if (tid < 128) { const f32x4 p0 = *(const f32x4*)(STV + (size_t)(m0 + tid) * 4), p1 = *(const f32x4*)(STV + (size_t)(m0 + tid) * 4 + 2);
                const float mean = ((p0[0] + p0[2]) + (p1[0] + p1[2])) * (1.f / 256.f), ex2 = ((p0[1] + p0[3]) + (p1[1] + p1[3])) * (1.f / 256.f);
                float var = ex2 - mean * mean; var = var > 0.f ? var : 0.f; ST[tid] = (f32x2){mean, 1.0f / sqrtf(var + EPS)}; }
            if (newg) {
#pragma unroll
            for (int i = 0; i < 8; ++i) { const int e = (tid + 512 * i) * 4, t = e >> 7, s0 = e & 127;
                const float w0 = (s0 + 0 <= t) ? wv[i][0] : 0.f, w1 = (s0 + 1 <= t) ? wv[i][1] : 0.f, w2 = (s0 + 2 <= t) ? wv[i][2] : 0.f, w3 = (s0 + 3 <= t) ? wv[i][3] : 0.f;
                *(LAS v2u*)(Wb + t * WLD + s0) = (v2u){pk2(w0, w1), pk2(w2, w3)}; } }
            __syncthreads();
            { const int t = tid >> 2, c16 = (tid & 3) * 16; const f32x2 st = ST[t];
              const v4u z0 = *(const v4u*)(GS + (size_t)(m0 + t) * 512 + 256 + g * 64 + c16), z1 = *(const v4u*)(GS + (size_t)(m0 + t) * 512 + 256 + g * 64 + c16 + 8);
              const float x[16] = {bflo(z0.x), bfhi(z0.x), bflo(z0.y), bfhi(z0.y), bflo(z0.z), bfhi(z0.z), bflo(z0.w), bfhi(z0.w), bflo(z1.x), bfhi(z1.x), bflo(z1.y), bfhi(z1.y), bflo(z1.z), bfhi(z1.z), bflo(z1.w), bfhi(z1.w)};
#pragma unroll
              for (int k4 = 0; k4 < 4; ++k4) { const f32x4 gv = *(const f32x4*)(lg + g * 64 + c16 + 4 * k4), bv = *(const f32x4*)(lb + g * 64 + c16 + 4 * k4);
#pragma unroll
                  for (int k = 0; k < 4; ++k) { const float o = (x[4 * k4 + k] - st.x) * st.y * gv[k] + bv[k]; VT[(c16 + 4 * k4 + k) * WLD + t] = (bf16)(pk2(o, 0.f) & 0xffffu); } } }
            __syncthreads();
            { const int t0 = wave * 16, fr = lane & 15, fq = lane >> 4; const int nks = (t0 + 15) / 32 + 1;
              f32x4 acc[4];
#pragma unroll
              for (int ct = 0; ct < 4; ++ct) acc[ct] = (f32x4){0.f, 0.f, 0.f, 0.f};
              for (int ks = 0; ks < nks; ++ks) { const bf16x8_t af = *(const LAS bf16x8_t*)(Wb + (t0 + fr) * WLD + 32 * ks + 8 * fq);
#pragma unroll
                  for (int ct = 0; ct < 4; ++ct) { const bf16x8_t bf = *(const LAS bf16x8_t*)(VT + (16 * ct + fr) * WLD + 32 * ks + 8 * fq);
                      acc[ct] = __builtin_amdgcn_mfma_f32_16x16x32_bf16(af, bf, acc[ct], 0, 0, 0); } }
              unsigned short uu[4][4]; float bias[4];
#pragma unroll
              for (int r = 0; r < 4; ++r) { const int t = t0 + 4 * fq + r; bias[r] = sb[g * 128 + t];
                  const unsigned short* up = (const unsigned short*)(GS + (size_t)(m0 + t) * 512 + g * 64 + fr);
#pragma unroll
                  for (int ct = 0; ct < 4; ++ct) uu[r][ct] = up[16 * ct]; }
#pragma unroll
              for (int r = 0; r < 4; ++r) { const int t = t0 + 4 * fq + r; bf16* op = Fb + (size_t)(m0 + t) * KCAT + F_SGU + g * 64 + fr;
#pragma unroll
                  for (int ct = 0; ct < 4; ++ct) { const float u = __uint_as_float((unsigned)uu[r][ct] << 16); op[16 * ct] = (bf16)(pk2(u * (acc[ct][r] + bias[r]), 0.f) & 0xffffu); } } }
            __syncthreads();
        }
    }
}

__device__ __forceinline__ void moe_offsets(Frame& F, int (&toff)[9]) {
    int acc = 0, c[8];
#pragma unroll
    for (int e = 0; e < 8; ++e) c[e] = (int)__hip_atomic_load((unsigned*)(F.ctl + CW_MOE + 64 * e), RLX_AGENT);
#pragma unroll
    for (int e = 0; e < 8; ++e) { toff[e] = acc; acc += (c[e] + 255) >> 8; }
    toff[8] = acc;
}
__device__ __forceinline__ void p_gather(Frame& F, const bf16* XN) {
    const int lane_v = lane_id(), tid_v = F.wave * 64 + lane_v; (void)tid_v;
    int toff[9]; moe_offsets(F, toff);
    int* tok_e = (int*)(F.ws + WS_TOK); int* tok_p = tok_e + 2 * M;
    bf16* XP = (bf16*)(F.ws + WS_XP);
    for (int m = F.gw; m < M; m += F.NGW) {
        const int e0 = tok_e[2 * m], e1 = tok_e[2 * m + 1]; int r0 = 0, r1 = 0;
#pragma unroll
        for (int e = 0; e < 8; ++e) { if (e == e0) r0 = toff[e] * 256; if (e == e1) r1 = toff[e] * 256; }
        r0 += tok_p[2 * m]; r1 += tok_p[2 * m + 1];
        const v4u a0 = __builtin_nontemporal_load((const v4u*)((const unsigned char*)XN + (size_t)m * XLD * 2 + 16 * lane_v));
        *(v4u*)((unsigned char*)XP + (size_t)r0 * DM * 2 + 16 * lane_v) = a0;
        *(v4u*)((unsigned char*)XP + (size_t)r1 * DM * 2 + 16 * lane_v) = a0;
        if (lane_v == 0) { const float sc = ((const float*)(F.ws + WS_SXN))[m]; ((float*)(F.ws + WS_SXP))[r0] = sc; ((float*)(F.ws + WS_SXP))[r1] = sc; }
        if (lane_v == 0) { tok_p[2 * m] = r0; tok_p[2 * m + 1] = r1; }
    }
    for (int idx = F.gw; idx < 8 * 256; idx += F.NGW) { const int e = idx >> 8, j = idx & 255;
        const int c = (int)__hip_atomic_load((unsigned*)(F.ctl + CW_MOE + 64 * e), RLX_AGENT); const int end = ((c + 255) >> 8) << 8;
        if (c + j < end) { int base = 0;
#pragma unroll
            for (int k = 0; k < 8; ++k) if (k == e) base = toff[k] * 256;
            const size_t r = (size_t)(base + c + j);
            *(v4u*)((unsigned char*)XP + r * DM * 2 + 16 * lane_v) = (v4u){0u, 0u, 0u, 0u}; if (lane_v == 0) ((float*)(F.ws + WS_SXP))[r] = 1.0f; } }
}
__device__ __forceinline__ void p_final(Frame& F, float* out, const float* g) {
    const int lane_v = lane_id(), tid_v = F.wave * 64 + lane_v; (void)tid_v;
    const int* tok_e = (const int*)(F.ws + WS_TOK); const int* tok_p = tok_e + 2 * M; const float* tok_w = (const float*)(tok_p + 2 * M);
    int toff[9]; moe_offsets(F, toff);
    const bf16* Y = (const bf16*)(F.ws + WS_XP);
    int lane_ = lane_v; asm volatile("" : "+v"(lane_));
    const GAS f32x4* gp = (const GAS f32x4*)g + lane_; f32x4 gv[4];
#pragma unroll
    for (int j = 0; j < 4; ++j) gv[j] = gp[64 * j];
    for (int m0 = F.gw; m0 < M; m0 += 2 * F.NGW) {
        int pr[2][2]; float wr_[2][2]; f32x4 xv[2][4]; unsigned ya_[2][4], yb_[2][4];
#pragma unroll
        for (int r = 0; r < 2; ++r) { const int mr = m0 + r * F.NGW, m = mr < M ? mr : m0;
            int p0 = tok_p[2 * m], p1 = tok_p[2 * m + 1]; { const int e0 = tok_e[2 * m], e1 = tok_e[2 * m + 1];
#pragma unroll
                for (int e = 0; e < 8; ++e) { if (e == e0) p0 += toff[e] * 256; if (e == e1) p1 += toff[e] * 256; } }
            pr[r][0] = p0; pr[r][1] = p1; wr_[r][0] = tok_w[2 * m]; wr_[r][1] = tok_w[2 * m + 1];
            const GAS v2u* xr = (const GAS v2u*)((const bf16*)(F.ws + WS_XRB) + (size_t)m * DM) + lane_;
            const GAS unsigned* y0 = (const GAS unsigned*)((const unsigned char*)Y + (size_t)(p0 < 32768 ? p0 : 0) * DM) + lane_; const GAS unsigned* y1 = (const GAS unsigned*)((const unsigned char*)Y + (size_t)(p1 < 32768 ? p1 : 0) * DM) + lane_;
#pragma unroll
            for (int j = 0; j < 4; ++j) { const v2u z = xr[64 * j]; xv[r][j] = (f32x4){bflo(z.x), bfhi(z.x), bflo(z.y), bfhi(z.y)}; ya_[r][j] = y0[64 * j]; yb_[r][j] = y1[64 * j]; } }
#pragma unroll
        for (int r = 0; r < 2; ++r) { const int m = m0 + r * F.NGW; if (m < M) {
            const int p0 = pr[r][0], p1 = pr[r][1]; const float w0 = wr_[r][0] * (p0 >= 32768 ? 1.0f : 1.0f / F8_SY), w1 = wr_[r][1] * (p1 >= 32768 ? 1.0f : 1.0f / F8_SY);
            f32x4 ya[4], yb[4];
#pragma unroll
            for (int j = 0; j < 4; ++j) { const unsigned a = ya_[r][j], b = yb_[r][j]; const auto a0 = __builtin_amdgcn_cvt_pk_f32_fp8(a, false), a1 = __builtin_amdgcn_cvt_pk_f32_fp8(a, true), b0 = __builtin_amdgcn_cvt_pk_f32_fp8(b, false), b1 = __builtin_amdgcn_cvt_pk_f32_fp8(b, true);
                ya[j] = (f32x4){a0[0], a0[1], a1[0], a1[1]}; yb[j] = (f32x4){b0[0], b0[1], b1[0], b1[1]}; }
            if (p0 >= 32768) {
#pragma unroll
                for (int j = 0; j < 4; ++j) { ya[j] = (f32x4){0.f, 0.f, 0.f, 0.f};
#pragma unroll
                    for (int ks = 0; ks < 7; ++ks) ya[j] += ((const GAS f32x4*)((const float*)(F.ws + WS_YF) + (size_t)ks * (8 * 256 * DM) + (size_t)(p0 - 32768) * DM) + lane_)[64 * j];
                    { const unsigned q = f8x4(ya[j][0] * F8_SY, ya[j][1] * F8_SY, ya[j][2] * F8_SY, ya[j][3] * F8_SY); const auto a0 = __builtin_amdgcn_cvt_pk_f32_fp8(q, false), a1 = __builtin_amdgcn_cvt_pk_f32_fp8(q, true); ya[j] = (f32x4){a0[0], a0[1], a1[0], a1[1]} * (1.0f / F8_SY); } } }
            if (p1 >= 32768) {
#pragma unroll
                for (int j = 0; j < 4; ++j) { yb[j] = (f32x4){0.f, 0.f, 0.f, 0.f};
#pragma unroll
                    for (int ks = 0; ks < 7; ++ks) yb[j] += ((const GAS f32x4*)((const float*)(F.ws + WS_YF) + (size_t)ks * (8 * 256 * DM) + (size_t)(p1 - 32768) * DM) + lane_)[64 * j];
                    { const unsigned q = f8x4(yb[j][0] * F8_SY, yb[j][1] * F8_SY, yb[j][2] * F8_SY, yb[j][3] * F8_SY); const auto b0 = __builtin_amdgcn_cvt_pk_f32_fp8(q, false), b1 = __builtin_amdgcn_cvt_pk_f32_fp8(q, true); yb[j] = (f32x4){b0[0], b0[1], b1[0], b1[1]} * (1.0f / F8_SY); } } }
            f32x4 v[4]; float s = 0.f;
#pragma unroll
            for (int j = 0; j < 4; ++j) { v[j] = xv[r][j] + ya[j] * w0 + yb[j] * w1; s += (v[j].x * v[j].x + v[j].y * v[j].y) + (v[j].z * v[j].z + v[j].w * v[j].w); }
            const float rs = 1.0f / sqrtf(wave_sum(s) * (1.f / DM) + EPS);
            GAS f32x4* xo = (GAS f32x4*)(out + (size_t)m * DM) + lane_;
#pragma unroll
            for (int j = 0; j < 4; ++j) xo[64 * j] = v[j] * rs * gv[j];
        } }
    }
}

constexpr int PL = 14, NPH = 1 + 2 * PL;
#ifndef PHMASK
#define PHMASK 0xFFFFFFFFu
#endif
#define EN(k) (((PHMASK) >> (k)) & 1u)
#ifndef REPMASK
#define REPMASK 0u
#endif
#ifndef REPCNT
#define REPCNT 1
#endif
#if REPMASK != 0
#define REP(k) for (int rep_ = 0; rep_ < 1 + REPCNT * (int)(((REPMASK) >> (k)) & 1u); ++rep_)
#else
#define REP(k)
#endif
#define IN(k) (lo <= (k) && (k) < hi)
#ifndef PROBE_BAR
#define PROBE_BAR 0
#endif
#define SEAM(k) do { if (lo <= (k) && (k) + 1 < hi) { xcd_barrier(bar); for (int pb_ = 0; pb_ < PROBE_BAR; ++pb_) xcd_barrier(bar); } } while (0)
template <int l> __device__ __forceinline__ void run_layer(Frame& F, const Args& args, const XcdBarrier& bar, const int lo, const int hi) {
    unsigned char* ws = F.ws; LAS unsigned char* ring = F.lds; float* XR = args.out; unsigned char* lds = (unsigned char*)F.lds; bf16* XRB = (bf16*)(ws + WS_XRB); (void)XR;
        const int pb = 1 + l * PL;
        bf16* XN = (bf16*)(ws + WS_XN);
        if (l == 1) { REP(1) if (EN(1) && IN(pb + 0)) { p_norm<false, true, true>(F, (const float*)XRB, args.in[1] + l * DM, XN, nullptr, nullptr, (float*)(ws + WS_SXQ)); SEAM(pb + 0); } }
        if (l == 0) { if (EN(1) && IN(pb + 0)) {
                quant_rows((bf16*)(ws + WS_WGU0), 2 * DFF, DM, (float*)(ws + WS_SWGU0), F.gw, F.NGW);
                { quant_rows((bf16*)(ws + WS_WIN), NZ, XLD, (float*)(ws + WS_SWIN), F.gw, F.NGW); quant_rows((bf16*)(ws + WS_WIN + SZ_WIN), NZ, XLD, (float*)(ws + WS_SWIN) + NZ, F.gw, F.NGW); }
            SEAM(pb + 0); } }
        REP(2) if (EN(2) && IN(pb + 1)) {
            WinOrder S; S.c = (int)blockIdx.x; S.G = F.G; S.A = (const char*)XN; S.B = (const char*)(ws + WS_WIN + l * SZ_WIN); S.a_tile = (size_t)256 * XLD * 2; S.b_tile = (size_t)256 * XLD * 2; S.nt = DM / 128;
            EpiZ2T<true> E{ws, (const float*)(ws + WS_SXQ), (const float*)(ws + WS_SWIN) + l * NZ};
            pg8::gemm_phase<EpiZ2T<true>, WinOrder, true, 1>(ring, pg8::Gemm{XLD, XLD}, S, E, F.wave);
            SEAM(pb + 1);
        }
        if (EN(3) && IN(pb + 2)) {
            p_thin(F, args, l);
#if (REPMASK & 8)
            for (int rp_ = 0; rp_ < REPCNT; ++rp_) { __syncthreads(); p_thin(F, args, l); }
#endif
            { TileOrder S; S.so.init(M, 768, F.G, (int)blockIdx.x); S.A = (const char*)(ws + WS_ZQ); S.B = (const char*)(ws + WS_WUQ + l * SZ_WUQ); S.a_tile = (size_t)256 * 256 * 2; S.b_tile = (size_t)256 * 256 * 2; S.nt = 4;
              EpiQ E{(bf16*)(ws + WS_QRAW), (const float*)(ws + WS_SSQ), (const float*)(ws + WS_CS)};
              pg8::gemm_phase<EpiQ, TileOrder, true>(ring, pg8::Gemm{256, 256}, S, E, F.wave); }
            { TileOrder S; S.so.init(M, 1024, F.G, (int)blockIdx.x); S.A = (const char*)(ws + WS_ZKV); S.B = (const char*)(ws + WS_WUKV + l * SZ_WUKV); S.a_tile = (size_t)256 * 256 * 2; S.b_tile = (size_t)256 * 256 * 2; S.nt = 4;
              EpiKV E{(bf16*)(ws + WS_KF), (bf16*)(ws + WS_VB), (const float*)(ws + WS_SSK)};
              pg8::gemm_phase<EpiKV, TileOrder, true>(ring, pg8::Gemm{256, 256}, S, E, F.wave); }
#if (REPMASK & 0x40000)
            for (int rp_ = 0; rp_ < REPCNT; ++rp_) {
            { TileOrder S; S.so.init(M, 768, F.G, (int)blockIdx.x); S.A = (const char*)(ws + WS_ZQ); S.B = (const char*)(ws + WS_WUQ + l * SZ_WUQ); S.a_tile = (size_t)256 * 256 * 2; S.b_tile = (size_t)256 * 256 * 2; S.nt = 4;
              EpiQ E{(bf16*)(ws + WS_QRAW), (const float*)(ws + WS_SSQ), (const float*)(ws + WS_CS)};
              pg8::gemm_phase<EpiQ, TileOrder, true>(ring, pg8::Gemm{256, 256}, S, E, F.wave); }
            { TileOrder S; S.so.init(M, 1024, F.G, (int)blockIdx.x); S.A = (const char*)(ws + WS_ZKV); S.B = (const char*)(ws + WS_WUKV + l * SZ_WUKV); S.a_tile = (size_t)256 * 256 * 2; S.b_tile = (size_t)256 * 256 * 2; S.nt = 4;
              EpiKV E{(bf16*)(ws + WS_KF), (bf16*)(ws + WS_VB), (const float*)(ws + WS_SSK)};
              pg8::gemm_phase<EpiKV, TileOrder, true>(ring, pg8::Gemm{256, 256}, S, E, F.wave); }
            }
#endif
            SEAM(pb + 3);
        }
        REP(5) if (EN(5) && IN(pb + 4)) {
            for (int pid = blockIdx.x; pid < 256; pid += F.G) { const int bh = 2 * (pid & 7) + (pid >> 7), s = (pid >> 3) & 15;
                att2::attn_unit<8>(bh >> 3, bh & 7, 31 - s, (const att2::bf16*)(ws + WS_QRAW), (const att2::bf16*)(ws + WS_KF), (const att2::bf16*)(ws + WS_VB), (att2::bf16*)(ws + WS_F), (char*)lds, F.wave);
                att2::attn_unit<8>(bh >> 3, bh & 7, s, (const att2::bf16*)(ws + WS_QRAW), (const att2::bf16*)(ws + WS_KF), (const att2::bf16*)(ws + WS_VB), (att2::bf16*)(ws + WS_F), (char*)lds, F.wave); }
            SEAM(pb + 4);
        }
        REP(6) if (EN(6) && IN(pb + 5)) {
            BranchOrder S; S.so.init(M, DM, F.G, (int)blockIdx.x); S.XNp = (const char*)XN; S.Wz = (const char*)(ws + WS_WIN + l * SZ_WIN) + (size_t)1792 * XLD * 2; S.Fp = (const char*)(ws + WS_F); S.Wc = (const char*)(ws + WS_WCAT + l * SZ_WCAT);
            EpiGate E{(bf16*)(ws + WS_TG) + (size_t)blockIdx.x * 65536, args.in[3] + l * 4096, (bf16*)(ws + WS_MG), (const float*)(ws + WS_SXQ), (const float*)(ws + WS_SWIN) + l * NZ + 1792};
            pg8::gemm_phase<EpiGate, BranchOrder, true, 2>(ring, pg8::Gemm{XLD, KCAT}, S, E, F.wave);
#if (REPMASK & 0x10000)
            for (int rp_ = 0; rp_ < REPCNT; ++rp_) pg8::gemm_phase<EpiGate, BranchOrder, true>(ring, pg8::Gemm{XLD, KCAT}, S, E, F.wave);
#endif
            SEAM(pb + 5);
        }
        REP(7) if (EN(7) && IN(pb + 6)) {
            TileOrder S; S.so.init(M, DM, F.G, (int)blockIdx.x); S.A = (const char*)(ws + WS_MG); S.B = (const char*)(ws + WS_WO + l * SZ_WO); S.a_tile = (size_t)256 * DM * 2; S.b_tile = (size_t)256 * DM * 2; S.nt = DM / 64;
            if constexpr (l == 0) { EpiResB<float> E{args.in[0], XRB, 1.0f}; pg8::gemm_phase<EpiResB<float>, TileOrder, true>(ring, pg8::Gemm{DM, DM}, S, E, F.wave); }
            else { EpiResB<bf16> E{XRB, XRB, 1.0f}; pg8::gemm_phase<EpiResB<bf16>, TileOrder, true>(ring, pg8::Gemm{DM, DM}, S, E, F.wave); }
            SEAM(pb + 6);
        }
        if (l == 0) {
            REP(8) if (EN(8) && IN(pb + 7)) { p_norm<false, true, true>(F, (const float*)XRB, args.in[23] + l * DM, XN, nullptr, nullptr, (float*)(ws + WS_SXN)); SEAM(pb + 7); }
            REP(9) if (EN(9) && IN(pb + 8)) {
                TileOrder S; S.so.init(M, 2 * DFF, F.G, (int)blockIdx.x); S.A = (const char*)XN; S.B = (const char*)(ws + WS_WGU0); S.a_tile = (size_t)256 * XLD * 2; S.b_tile = (size_t)256 * DM * 2; S.nt = DM / 128;
                EpiSwiGLUT<true, true> E{(bf16*)(ws + WS_H), DFF, 0, (const float*)(ws + WS_SXN), (const float*)(ws + WS_SWGU0)};
                pg8::gemm_phase<EpiSwiGLUT<true, true>, TileOrder, true, 1>(ring, pg8::Gemm{XLD, DM}, S, E, F.wave);
                SEAM(pb + 8);
            }
            REP(10) if (EN(10) && IN(pb + 9)) {
                TileOrder S; S.so.init(M, DM, F.G, (int)blockIdx.x); S.A = (const char*)(ws + WS_H); S.B = (const char*)(ws + WS_WD0); S.a_tile = (size_t)256 * DFF; S.b_tile = (size_t)256 * DFF; S.nt = DFF / 128;
                EpiResB<bf16> E{XRB, XRB, 1.0f / (F8_SH * F8_SW)};
                pg8::gemm_phase<EpiResB<bf16>, TileOrder, true, 3>(ring, pg8::Gemm{DFF / 2, DFF / 2}, S, E, F.wave);
                SEAM(pb + 9 + 4);
            }
        } else {
            REP(11) if (EN(11) && IN(pb + 7)) { p_norm<true, true, true>(F, (const float*)XRB, args.in[23] + l * DM, (bf16*)(ws + WS_XN2), args.in[27], args.in[28], (float*)(ws + WS_SXN)); SEAM(pb + 7); }
            for (int ch = 0; ch < 1; ++ch) {
                int toff[9];
                REP(13) if (EN(13) && IN(pb + 9 + 2 * ch)) {
                    moe_offsets(F, toff); const int rt0 = ch * MOE_CH, rt1 = toff[8] < (ch + 1) * MOE_CH ? toff[8] : (ch + 1) * MOE_CH;
                    if (rt1 > rt0) {
                        MoeOrder S; S.so.nM = rt1; S.so.nN = 2 * DFFE / 256; S.so.nwg = rt1 * (2 * DFFE / 256); S.so.G = F.G; S.so.c = (int)blockIdx.x; S.nt = DM / 128;
                        S.A = (const char*)(ws + WS_XN2); S.B = (const char*)(ws + WS_MGU); S.a_tile = 0; S.b_tile = (size_t)256 * DM; S.b_exp = SZ_MGU8; S.tix = (const int*)(ws + WS_TIX);
#pragma unroll
                        for (int k = 0; k < 9; ++k) S.toff[k] = toff[k];
#pragma unroll
                        for (int k = 0; k < 8; ++k) S.cnt[k] = (int)__hip_atomic_load((unsigned*)(F.ctl + CW_MOE + 64 * k), RLX_AGENT);
#if MOE_UP_F8
                        EpiSwiGLUT<false, true, true> E{(bf16*)(ws + WS_HC), DFFE, rt0, (const float*)(ws + WS_SXN), (const float*)(ws + WS_SWMOE)};
                        pg8::gemm_phase<EpiSwiGLUT<false, true, true>, MoeOrder, true, 3, true>(ring, pg8::Gemm{XLD, DM / 2}, S, E, F.wave);
#else
                        EpiSwiGLUT<true, true> E{(bf16*)(ws + WS_HC), DFFE, rt0, (const float*)(ws + WS_SXN), (const float*)(ws + WS_SWMOE)};
                        pg8::gemm_phase<EpiSwiGLUT<true, true>, MoeOrder, true, 1, true>(ring, pg8::Gemm{XLD, DM / 2}, S, E, F.wave);
#endif
                    }
                    SEAM(pb + 9 + 2 * ch);
                }
                REP(14) if (EN(14) && IN(pb + 10 + 2 * ch)) {
                    moe_offsets(F, toff); const int rt0 = ch * MOE_CH, rt1 = toff[8] < (ch + 1) * MOE_CH ? toff[8] : (ch + 1) * MOE_CH;
                    if (rt1 > rt0) {
                        const int nreg = rt1 < 128 ? rt1 : 128;
                        MoeDownOrder S; S.so.nM = nreg; S.so.nN = DM / 256; S.so.nwg = nreg * (DM / 256); S.so.G = F.G; S.so.c = 0; S.G = F.G; S.c = (int)blockIdx.x; S.nsub = (rt1 - nreg) * 28;
                        S.A = (const char*)(ws + WS_HC); S.B = (const char*)(ws + WS_MD); S.a_tile = (size_t)256 * DFFE; S.b_tile = (size_t)256 * DFFE; S.b_exp = SZ_MD / 2;
#pragma unroll
                        for (int k = 0; k < 9; ++k) S.toff[k] = toff[k];
                        EpiMoeDown E{(bf16*)(ws + WS_XP), (float*)(ws + WS_YF)};
                        pg8::gemm_phase<EpiMoeDown, MoeDownOrder, true, 3>(ring, pg8::Gemm{DFFE / 2, DFFE / 2}, S, E, F.wave);
                    }
                    SEAM(pb + 12);
                }
            }
            REP(15) if (EN(15) && IN(pb + 13)) { p_final(F, XR, args.in[32]); }
        }
    }
__global__ void __launch_bounds__(NWAVES * 64, 2) fwd_kernel(Args args_in_kernarg) {
    const Args& args = *(const Args*)__builtin_amdgcn_kernarg_segment_ptr();
    extern __shared__ __attribute__((aligned(16))) unsigned char lds[];
    Frame F;
    F.lds = (LAS unsigned char*)lds; F.MISC = (volatile LAS unsigned*)(F.lds + MISC_OFF);
    F.wave = __builtin_amdgcn_readfirstlane((int)threadIdx.x >> 6);
    F.G = gridDim.x; F.gw = blockIdx.x * NWAVES + F.wave; F.NGW = F.G * NWAVES;
    F.ws = args.ws; F.ctl = (gu32*)(args.ws + WS_CTL);
    unsigned char* ws = args.ws;
    for (int u = threadIdx.x; u < (LDS_BYTES - LDSCTL_OFF) / 4; u += NWAVES * 64) ((LAS unsigned*)(F.lds + LDSCTL_OFF))[u] = 0u;
    __syncthreads();
    XcdBarrier bar; bar.bar = (unsigned*)(F.ctl + CW_BAR); bar.x = 0; bar.st = nullptr;
    const int lo = args.ph_lo, hi = args.ph_hi;
    if (hi - lo > 1) bar = xcd_barrier_post((unsigned*)(F.ctl + CW_BAR), F.MISC + 8);
    bar.wave = F.wave;
    LAS unsigned char* ring = F.lds;
    float* XR = args.out;

    if (EN(0) && IN(0)) { p_prologue(F, args); p_norm<false, true>(F, args.in[0], args.in[1], (bf16*)(ws + WS_XN), nullptr, nullptr, (float*)(ws + WS_SXQ));
#if (REPMASK & 1)
        for (int rp_ = 0; rp_ < REPCNT; ++rp_) { __syncthreads(); p_prologue(F, args); }
#endif
        SEAM(0); }

    run_layer<0>(F, args, bar, lo, hi);
    run_layer<1>(F, args, bar, lo, hi);
}

extern "C" void kernel_launch(void* const* d_in, const int* in_sizes, int n_in, void* d_out, int out_size, void* d_ws, size_t ws_size, hipStream_t stream) {
    static int grid = 0;
    if (grid == 0) {
        if (n_in != 33 || in_sizes[0] != M * DM || out_size != M * DM || ws_size < WS_END) {
            fprintf(stderr, "kernel_launch: unexpected shapes: n_in %d in0 %d out %d ws %zu (need >= %zu)\n", n_in, n_in > 0 ? in_sizes[0] : -1, out_size, ws_size, (size_t)WS_END); grid = -1; return; }
        int dev = 0, cus = 0, per_cu = 0;
        if (hipGetDevice(&dev) != hipSuccess || hipDeviceGetAttribute(&cus, hipDeviceAttributeMultiprocessorCount, dev) != hipSuccess) { grid = -1; return; }
        if (hipFuncSetAttribute((const void*)fwd_kernel, hipFuncAttributeMaxDynamicSharedMemorySize, LDS_BYTES) != hipSuccess) { fprintf(stderr, "kernel_launch: hipFuncSetAttribute failed\n"); grid = -1; return; }
        if (hipOccupancyMaxActiveBlocksPerMultiprocessor(&per_cu, (const void*)fwd_kernel, NWAVES * 64, LDS_BYTES) != hipSuccess || per_cu < 1)
            fprintf(stderr, "kernel_launch: occupancy query reports %d blocks per CU\n", per_cu);
        (void)hipGetLastError();
        grid = cus;
    }
    if (grid < 0) return;
    if (hipMemsetAsync((char*)d_ws + WS_CTL, 0, CTL_ZERO_BYTES, stream) != hipSuccess) return;
    Args a{};
    for (int i = 0; i < 33; ++i) a.in[i] = (const float*)d_in[i];
    a.out = (float*)d_out; a.ws = (unsigned char*)d_ws; a.li = 0; a.pad = 0;
#if NLAUNCH_MODE == 1
    a.ph_lo = 0; a.ph_hi = NPH;
    hipLaunchKernelGGL(fwd_kernel, dim3(grid), dim3(NWAVES * 64), LDS_BYTES, stream, a);
#else
    for (int ph = 0; ph < NPH; ++ph) {
        if ((ph >= 1 + 10 && ph <= 1 + 13) || ph == 1 + PL + 8 || ph == 1 + PL + 11 || ph == 1 + PL + 12 || ph == 1 + 3 || ph == 1 + PL + 3) continue;
        a.ph_lo = ph; a.ph_hi = ph + 1; a.li = 0;
        hipLaunchKernelGGL(fwd_kernel, dim3(grid), dim3(NWAVES * 64), LDS_BYTES, stream, a);
    }
#endif
    const hipError_t le = hipPeekAtLastError();
    if (le != hipSuccess) fprintf(stderr, "kernel_launch: launch failed: %s\n", hipGetErrorName(le));
}
```
